# Optimizing an MI355X kernel written in HIP

```python
import jax, jax.numpy as jnp
from jax import lax
import numpy as np

D_MODEL = 1024
BATCH = 4
SEQ = 4096
DEPTH = 1

FFN_HIDDEN = 2816
FFN_RESIDUAL_WEIGHT = 0.5

MLA_HEADS = 8
MLA_NOPE_DIM = 64
MLA_ROPE_DIM = 32
MLA_V_DIM = 64
Q_LORA_RANK = 192
KV_LORA_RANK = 128
ROPE_THETA = 10000.0
MAX_POS_OFFSET = 1024

FOX_HEADS = 8
FOX_HEAD_DIM = 64
FOX_WIDTH = FOX_HEADS * FOX_HEAD_DIM
FOX_BF_MIN = 1.0
FOX_BF_MAX = 6.0

MLA_WIDTH = MLA_HEADS * MLA_V_DIM
Q_BLOCK = 128
RMS_EPS = 1e-6

IN_SPLIT_SIZES = (Q_LORA_RANK, KV_LORA_RANK, MLA_ROPE_DIM,
                  FOX_WIDTH, FOX_WIDTH, FOX_WIDTH, FOX_HEADS,
                  D_MODEL, D_MODEL)
IN_WIDTH = sum(IN_SPLIT_SIZES)

kernel_name = "hybrid_mla_fox_macaron_gated"


def rms_norm(x, gain):
    xf = x.astype(jnp.float32)
    y = xf * lax.rsqrt(jnp.mean(xf * xf, axis=-1, keepdims=True) + RMS_EPS)
    return (y * gain.astype(jnp.float32)).astype(x.dtype)


def swiglu(x, w_gate, w_up, w_down):
    return (jax.nn.silu(x @ w_gate) * (x @ w_up)) @ w_down


def rope_tables(positions):
    half = MLA_ROPE_DIM // 2
    inv_freq = ROPE_THETA ** (-jnp.arange(half, dtype=jnp.float32) / half)
    ang = positions.astype(jnp.float32)[..., None] * inv_freq
    return jnp.cos(ang), jnp.sin(ang)


def apply_rotary(x, cos, sin):
    half = x.shape[-1] // 2
    xf = x.astype(jnp.float32)
    x1, x2 = xf[..., :half], xf[..., half:]
    return jnp.concatenate([x1 * cos - x2 * sin, x2 * cos + x1 * sin], axis=-1).astype(x.dtype)


def to_heads(t):
    return t.transpose(0, 2, 1, 3)


def from_heads(t):
    b, h, s, d = t.shape
    return t.transpose(0, 2, 1, 3).reshape(b, s, h * d)


def blocked_causal_attention(q, k, v, log_decay_cum=None):
    b, h, s, dk = q.shape
    dv = v.shape[-1]
    n_blocks = s // Q_BLOCK
    scale = dk ** -0.5
    k_pos = jnp.arange(s)

    def one_block(i):
        start = i * Q_BLOCK
        q_blk = lax.dynamic_slice_in_dim(q, start, Q_BLOCK, axis=2)
        logits = jnp.einsum('bhqd,bhkd->bhqk', q_blk, k,
                            preferred_element_type=jnp.float32) * scale
        if log_decay_cum is not None:
            c_q = lax.dynamic_slice_in_dim(log_decay_cum, start, Q_BLOCK, axis=2)
            logits = logits + (c_q[..., :, None] - log_decay_cum[..., None, :])
        q_pos = start + jnp.arange(Q_BLOCK)
        logits = jnp.where(k_pos[None, :] <= q_pos[:, None], logits, -jnp.inf)
        probs = jax.nn.softmax(logits, axis=-1)
        return jnp.einsum('bhqk,bhkd->bhqd', probs.astype(v.dtype), v)

    out = lax.map(one_block, jnp.arange(n_blocks))
    return out.transpose(1, 2, 0, 3, 4).reshape(b, h, s, dv)


def mla_mixer(q_lat, kv_lat, k_rope, cos, sin, q_lat_norm, w_qb, kv_lat_norm, w_kvb,
              q_nope_gain, q_rope_gain, k_nope_gain, k_rope_gain):
    b, s, _ = q_lat.shape
    q = (rms_norm(q_lat, q_lat_norm) @ w_qb).reshape(b, s, MLA_HEADS, MLA_NOPE_DIM + MLA_ROPE_DIM)
    q_nope = rms_norm(q[..., :MLA_NOPE_DIM], q_nope_gain)
    q_rope = apply_rotary(rms_norm(q[..., MLA_NOPE_DIM:], q_rope_gain),
                          cos[:, :, None, :], sin[:, :, None, :])
    kv = (rms_norm(kv_lat, kv_lat_norm) @ w_kvb).reshape(b, s, MLA_HEADS, MLA_NOPE_DIM + MLA_V_DIM)
    k_nope = rms_norm(kv[..., :MLA_NOPE_DIM], k_nope_gain)
    v = kv[..., MLA_NOPE_DIM:]
    k_r = apply_rotary(rms_norm(k_rope, k_rope_gain), cos, sin)
    k_r = jnp.broadcast_to(k_r[:, :, None, :], (b, s, MLA_HEADS, MLA_ROPE_DIM))
    q_full = jnp.concatenate([q_nope, q_rope], axis=-1)
    k_full = jnp.concatenate([k_nope, k_r], axis=-1)
    out = blocked_causal_attention(to_heads(q_full), to_heads(k_full), to_heads(v))
    return from_heads(out)


def fox_mixer(fq, fk, fv, f_logit, q_gain, k_gain, b_f):
    b, s, _ = fq.shape
    q = rms_norm(fq.reshape(b, s, FOX_HEADS, FOX_HEAD_DIM), q_gain)
    k = rms_norm(fk.reshape(b, s, FOX_HEADS, FOX_HEAD_DIM), k_gain)
    v = fv.reshape(b, s, FOX_HEADS, FOX_HEAD_DIM)
    log_f = jax.nn.log_sigmoid((f_logit + b_f).astype(jnp.float32))
    c = jnp.cumsum(log_f, axis=1).transpose(0, 2, 1)
    out = blocked_causal_attention(to_heads(q), to_heads(k), to_heads(v), c)
    return from_heads(out)


def setup_inputs(seed: int = 0) -> dict:
    key = jax.random.key(seed)
    ks = iter(jax.random.split(key, 40))
    f32 = jnp.float32

    def w(shape, fan_in):
        return jax.random.normal(next(ks), (DEPTH,) + shape, f32) * (fan_in ** -0.5)

    def gain(*shape):
        return 1.0 + 0.02 * jax.random.normal(next(ks), (DEPTH,) + shape, f32)

    x = jax.random.normal(next(ks), (BATCH, SEQ, D_MODEL), f32)
    offsets = jax.random.randint(next(ks), (BATCH, 1), 0, MAX_POS_OFFSET, dtype=jnp.int32)
    positions = (offsets + jnp.arange(SEQ, dtype=jnp.int32)[None, :]).astype(jnp.int32)
    return {
        "x": x,
        "positions": positions,
        "ffn1_norm": gain(D_MODEL),
        "ffn1_w_gate": w((D_MODEL, FFN_HIDDEN), D_MODEL),
        "ffn1_w_up": w((D_MODEL, FFN_HIDDEN), D_MODEL),
        "ffn1_w_down": w((FFN_HIDDEN, D_MODEL), FFN_HIDDEN),
        "mix_norm": gain(D_MODEL),
        "w_in": w((D_MODEL, IN_WIDTH), D_MODEL),
        "mla_q_lat_norm": gain(Q_LORA_RANK),
        "mla_w_qb": w((Q_LORA_RANK, MLA_HEADS * (MLA_NOPE_DIM + MLA_ROPE_DIM)), Q_LORA_RANK),
        "mla_kv_lat_norm": gain(KV_LORA_RANK),
        "mla_w_kvb": w((KV_LORA_RANK, MLA_HEADS * (MLA_NOPE_DIM + MLA_V_DIM)), KV_LORA_RANK),
        "mla_q_nope_gain": gain(MLA_NOPE_DIM),
        "mla_q_rope_gain": gain(MLA_ROPE_DIM),
        "mla_k_nope_gain": gain(MLA_NOPE_DIM),
        "mla_k_rope_gain": gain(MLA_ROPE_DIM),
        "fox_q_gain": gain(FOX_HEAD_DIM),
        "fox_k_gain": gain(FOX_HEAD_DIM),
        "fox_b_f": jax.random.uniform(next(ks), (DEPTH, FOX_HEADS), f32, FOX_BF_MIN, FOX_BF_MAX),
        "w_branch_mla": w((MLA_WIDTH, D_MODEL), MLA_WIDTH),
        "w_branch_fox": w((FOX_WIDTH, D_MODEL), FOX_WIDTH),
        "b_gate": 0.02 * jax.random.normal(next(ks), (DEPTH, 2, D_MODEL), f32),
        "w_o": w((D_MODEL, D_MODEL), D_MODEL),
        "ffn2_norm": gain(D_MODEL),
        "ffn2_w_gate": w((D_MODEL, FFN_HIDDEN), D_MODEL),
        "ffn2_w_up": w((D_MODEL, FFN_HIDDEN), D_MODEL),
        "ffn2_w_down": w((FFN_HIDDEN, D_MODEL), FFN_HIDDEN),
    }


def reference(x, positions, ffn1_norm, ffn1_w_gate, ffn1_w_up, ffn1_w_down, mix_norm, w_in,
              mla_q_lat_norm, mla_w_qb, mla_kv_lat_norm, mla_w_kvb, mla_q_nope_gain,
              mla_q_rope_gain, mla_k_nope_gain, mla_k_rope_gain, fox_q_gain, fox_k_gain,
              fox_b_f, w_branch_mla, w_branch_fox, b_gate, w_o, ffn2_norm, ffn2_w_gate,
              ffn2_w_up, ffn2_w_down):
    split_points = [int(p) for p in np.cumsum(IN_SPLIT_SIZES)[:-1]]
    cos, sin = rope_tables(positions)
    for l in range(DEPTH):
        x = x + FFN_RESIDUAL_WEIGHT * swiglu(rms_norm(x, ffn1_norm[l]),
                                             ffn1_w_gate[l], ffn1_w_up[l], ffn1_w_down[l])
        h = rms_norm(x, mix_norm[l])
        proj = h @ w_in[l]
        (q_lat, kv_lat, k_rope, fq, fk, fv, f_logit,
         g_mla, g_fox) = jnp.split(proj, split_points, axis=-1)
        y_mla = mla_mixer(q_lat, kv_lat, k_rope, cos, sin, mla_q_lat_norm[l], mla_w_qb[l],
                          mla_kv_lat_norm[l], mla_w_kvb[l], mla_q_nope_gain[l],
                          mla_q_rope_gain[l], mla_k_nope_gain[l], mla_k_rope_gain[l])
        y_fox = fox_mixer(fq, fk, fv, f_logit, fox_q_gain[l], fox_k_gain[l], fox_b_f[l])
        mixed = (jax.nn.sigmoid(g_mla + b_gate[l, 0]) * (y_mla @ w_branch_mla[l])
                 + jax.nn.sigmoid(g_fox + b_gate[l, 1]) * (y_fox @ w_branch_fox[l]))
        x = x + mixed @ w_o[l]
        x = x + FFN_RESIDUAL_WEIGHT * swiglu(rms_norm(x, ffn2_norm[l]),
                                             ffn2_w_gate[l], ffn2_w_up[l], ffn2_w_down[l])
    return x
```

```cpp
#include <hip/hip_runtime.h>
#include <cstdint>
#include <cstdio>
namespace nv {
constexpr int T = 4096, DM = 1024, FH = 2816, INW = 3944, NB = 4;
constexpr float EPS = 1e-6f;
__device__ __constant__ float INV_FREQ[16] = {1.0f, 0.5623413324356079f, 0.3162277638912201f, 0.17782793939113617f, 0.10000000149011612f, 0.05623413249850273f, 0.03162277489900589f, 0.017782794311642647f,
    0.009999999776482582f, 0.005623413249850273f, 0.003162277629598975f, 0.0017782794311642647f, 0.0010000000474974513f, 0.000562341301701963f, 0.0003162277571391314f, 0.00017782794020604342f};

__device__ __forceinline__ void sincos_acc(float af, float& s, float& c) {
    const double a = (double)af;
    const double k = rint(a * 0.6366197723675814);
    double r = fma(-k, 1.5707963267948966, a); r = fma(-k, 6.123233995736766e-17, r);
    const int q = ((int)k) & 3;
    const double r2 = r * r;
    double sp = -1.0 / 1307674368000.0; sp = fma(sp, r2, 1.0 / 6227020800.0); sp = fma(sp, r2, -1.0 / 39916800.0); sp = fma(sp, r2, 1.0 / 362880.0); sp = fma(sp, r2, -1.0 / 5040.0);
    sp = fma(sp, r2, 1.0 / 120.0); sp = fma(sp, r2, -1.0 / 6.0); sp = fma(sp, r2, 1.0); sp *= r;
    double cp = 1.0 / 20922789888000.0; cp = fma(cp, r2, -1.0 / 87178291200.0); cp = fma(cp, r2, 1.0 / 479001600.0); cp = fma(cp, r2, -1.0 / 3628800.0); cp = fma(cp, r2, 1.0 / 40320.0);
    cp = fma(cp, r2, -1.0 / 720.0); cp = fma(cp, r2, 1.0 / 24.0); cp = fma(cp, r2, -0.5); cp = fma(cp, r2, 1.0);
    const double ss = (q & 1) ? cp : sp, cc = (q & 1) ? sp : cp;
    s = (float)((q & 2) ? -ss : ss); c = (float)(((q + 1) & 2) ? -cc : cc);
}
__device__ __forceinline__ float sigmoidf_(float z) { return 1.0f / (1.0f + expf(-z)); }
__device__ __forceinline__ float logsigmoidf_(float z) { return z >= 0.f ? -log1pf(expf(-z)) : z - log1pf(expf(z)); }

__global__ void __launch_bounds__(256) k_rmsnorm(const float* in, int ldin, int gsin, float* out, int ldout, int gsout, const float* gain, int R, int G, int C) {
    const int idx = blockIdx.x * 256 + threadIdx.x; if (idx >= R * G) return;
    const int r = idx / G, g = idx % G;
    const float* p = in + (size_t)r * ldin + g * gsin; float s = 0.f;
    for (int c = 0; c < C; ++c) s += p[c] * p[c];
    const float rs = 1.0f / sqrtf(s / (float)C + EPS);
    float* o = out + (size_t)r * ldout + g * gsout;
    for (int c = 0; c < C; ++c) o[c] = p[c] * rs * gain[c];
}
__global__ void __launch_bounds__(256) k_gemm(const float* A, int lda, const float* B, int ldb, float* C, int ldc, int M, int N, int K) {
    __shared__ float As[16][68]; __shared__ float Bs[16][68];
    const int tid = threadIdx.x, tx = tid & 15, ty = tid >> 4, m0 = blockIdx.y * 64, n0 = blockIdx.x * 64;
    float acc[4][4];
#pragma unroll
    for (int i = 0; i < 4; ++i)
#pragma unroll
        for (int j = 0; j < 4; ++j) acc[i][j] = 0.f;
    for (int k0 = 0; k0 < K; k0 += 16) {
#pragma unroll
        for (int i = 0; i < 4; ++i) { const int idx = tid + 256 * i; const int r = idx >> 4, c = idx & 15; As[c][r] = A[(size_t)(m0 + r) * lda + k0 + c]; }
#pragma unroll
        for (int i = 0; i < 4; ++i) { const int idx = tid + 256 * i; const int r = idx >> 6, c = idx & 63; Bs[r][c] = (n0 + c < N) ? B[(size_t)(k0 + r) * ldb + n0 + c] : 0.f; }
        __syncthreads();
#pragma unroll
        for (int k = 0; k < 16; ++k) { float a[4], b[4];
#pragma unroll
            for (int i = 0; i < 4; ++i) { a[i] = As[k][ty * 4 + i]; b[i] = Bs[k][tx * 4 + i]; }
#pragma unroll
            for (int i = 0; i < 4; ++i)
#pragma unroll
                for (int j = 0; j < 4; ++j) acc[i][j] = fmaf(a[i], b[j], acc[i][j]); }
        __syncthreads();
    }
#pragma unroll
    for (int i = 0; i < 4; ++i)
#pragma unroll
        for (int j = 0; j < 4; ++j) { const int n = n0 + tx * 4 + j; if (n < N) C[(size_t)(m0 + ty * 4 + i) * ldc + n] = acc[i][j]; }
}
__global__ void __launch_bounds__(256) k_swiglu(float* g, const float* u, size_t n) { size_t i = (size_t)blockIdx.x * 256 + threadIdx.x; if (i < n) { const float z = g[i]; g[i] = z * sigmoidf_(z) * u[i]; } }
__global__ void __launch_bounds__(256) k_axpy(const float* base, const float* t, float alpha, float* out, size_t n) { size_t i = (size_t)blockIdx.x * 256 + threadIdx.x; if (i < n) out[i] = base[i] + alpha * t[i]; }
__global__ void __launch_bounds__(256) k_gate(float* br, const float* proj, int off, const float* bias) { size_t i = (size_t)blockIdx.x * 256 + threadIdx.x; const int r = (int)(i >> 10), c = (int)(i & 1023); if (r < T) br[i] *= sigmoidf_(proj[(size_t)r * INW + off + c] + bias[c]); }
__global__ void __launch_bounds__(256) k_add(float* a, const float* b, size_t n) { size_t i = (size_t)blockIdx.x * 256 + threadIdx.x; if (i < n) a[i] += b[i]; }

__global__ void __launch_bounds__(256) k_mla_qprep(const float* q, float* qf, const float* gn, const float* gr, const int* pos) {
    const int idx = blockIdx.x * 256 + threadIdx.x; if (idx >= T * 8) return;
    const int t = idx >> 3; const float* p = q + (size_t)idx * 96; float* o = qf + (size_t)idx * 96;
    float s = 0.f; for (int c = 0; c < 64; ++c) s += p[c] * p[c];
    float rs = 1.0f / sqrtf(s / 64.f + EPS); for (int c = 0; c < 64; ++c) o[c] = p[c] * rs * gn[c];
    s = 0.f; for (int c = 0; c < 32; ++c) s += p[64 + c] * p[64 + c];
    rs = 1.0f / sqrtf(s / 32.f + EPS);
    const float fp = (float)pos[t];
    for (int i = 0; i < 16; ++i) { float sn, cs; sincos_acc(fp * INV_FREQ[i], sn, cs); const float x1 = p[64 + i] * rs * gr[i], x2 = p[80 + i] * rs * gr[16 + i];
        o[64 + i] = x1 * cs - x2 * sn; o[80 + i] = x2 * cs + x1 * sn; }
}
__global__ void __launch_bounds__(256) k_mla_kprep(const float* kv, const float* proj, float* kf, const float* gn, const float* gr, const int* pos) {
    const int idx = blockIdx.x * 256 + threadIdx.x; if (idx >= T * 8) return;
    const int t = idx >> 3; const float* p = kv + (size_t)idx * 128; float* o = kf + (size_t)idx * 96;
    float s = 0.f; for (int c = 0; c < 64; ++c) s += p[c] * p[c];
    float rs = 1.0f / sqrtf(s / 64.f + EPS); for (int c = 0; c < 64; ++c) o[c] = p[c] * rs * gn[c];
    const float* kr = proj + (size_t)t * INW + 320;
    s = 0.f; for (int c = 0; c < 32; ++c) s += kr[c] * kr[c];
    rs = 1.0f / sqrtf(s / 32.f + EPS);
    const float fp = (float)pos[t];
    for (int i = 0; i < 16; ++i) { float sn, cs; sincos_acc(fp * INV_FREQ[i], sn, cs); const float x1 = kr[i] * rs * gr[i], x2 = kr[16 + i] * rs * gr[16 + i];
        o[64 + i] = x1 * cs - x2 * sn; o[80 + i] = x2 * cs + x1 * sn; }
}
__global__ void __launch_bounds__(64) k_cum(const float* proj, const float* bf, float* cum) {
    const int h = blockIdx.x, lane = threadIdx.x; float loc = 0.f;
    for (int i = 0; i < 64; ++i) loc += logsigmoidf_(proj[(size_t)(lane * 64 + i) * INW + 1888 + h] + bf[h]);
    float inc = loc;
    for (int o = 1; o < 64; o <<= 1) { const float v = __shfl_up(inc, o); if (lane >= o) inc += v; }
    float run = inc - loc;
    for (int i = 0; i < 64; ++i) { run += logsigmoidf_(proj[(size_t)(lane * 64 + i) * INW + 1888 + h] + bf[h]); cum[h * T + lane * 64 + i] = run; }
}
template <int DK>
__global__ void __launch_bounds__(256) k_attn(const float* Q, int ldq, int hq, const float* K, int ldk, int hk, const float* V, int ldv, int hv, float* out, const float* cum, float scale) {
    __shared__ float qs[4][DK];
    const int w = threadIdx.x >> 6, lane = threadIdx.x & 63, task = blockIdx.x * 4 + w, h = task & 7, qi = task >> 3;
    for (int d = lane; d < DK; d += 64) qs[w][d] = Q[(size_t)qi * ldq + h * hq + d];
    __syncthreads();
    float m = -1e30f, l = 0.f, o[64];
#pragma unroll
    for (int d = 0; d < 64; ++d) o[d] = 0.f;
    const float cq = cum ? cum[h * T + qi] : 0.f;
    for (int j = lane; j <= qi; j += 64) {
        const float* kp = K + (size_t)j * ldk + h * hk; float s = 0.f;
#pragma unroll 8
        for (int d = 0; d < DK; ++d) s = fmaf(qs[w][d], kp[d], s);
        s *= scale; if (cum) s += cq - cum[h * T + j];
        const float mn = fmaxf(m, s), corr = expf(m - mn), p = expf(s - mn);
        l = l * corr + p; m = mn;
        const float* vp = V + (size_t)j * ldv + h * hv;
#pragma unroll
        for (int d = 0; d < 64; ++d) o[d] = fmaf(o[d], corr, p * vp[d]);
    }
    float mall = m;
    for (int x = 1; x < 64; x <<= 1) mall = fmaxf(mall, __shfl_xor(mall, x));
    const float f = expf(m - mall); l *= f;
    for (int x = 1; x < 64; x <<= 1) l += __shfl_xor(l, x);
    float res = 0.f;
#pragma unroll
    for (int d = 0; d < 64; ++d) { float v = o[d] * f; for (int x = 1; x < 64; x <<= 1) v += __shfl_xor(v, x); if (lane == d) res = v; }
    out[(size_t)qi * 512 + h * 64 + lane] = res / l;
}

struct Hooks { int stage; void (*fn)(int stage, int b, float* S, hipStream_t st, void* user); void* user; };
constexpr size_t MiF = 262144;
constexpr size_t O_G = 0, O_U = (size_t)T * FH, O_PROJ = 0, O_XN = 88 * MiF, O_Q1 = 104 * MiF, O_KV = 116 * MiF, O_QF = 132 * MiF, O_KF = 144 * MiF, O_QN = 156 * MiF, O_KVN = 159 * MiF,
    O_FQ = 161 * MiF, O_FK = 169 * MiF, O_CUM = 177 * MiF, O_YM = 178 * MiF, O_YF = 186 * MiF, O_BR1 = 194 * MiF, O_BR2 = 210 * MiF;
#define NV_G1(n) dim3((unsigned)(((n) + 255) / 256)), dim3(256), 0, st
static void gemm(const float* A, int lda, const float* B, int ldb, float* C, int ldc, int M, int N, int K, hipStream_t st) { hipLaunchKernelGGL(k_gemm, dim3((N + 63) / 64, M / 64), dim3(256), 0, st, A, lda, B, ldb, C, ldc, M, N, K); }
static void forward(void* const* d_in, float* d_out, float* S, hipStream_t st, const Hooks* hk) {
    const float* x = (const float*)d_in[0]; const int* pos = (const int*)d_in[1];
#define IN(i) ((const float*)d_in[i])
#define HOOK(s) do { if (hk && hk->fn) hk->fn((s), b, S, st, hk->user); } while (0)
    for (int b = 0; b < NB; ++b) {
        const float* xb = x + (size_t)b * T * DM; float* ob = d_out + (size_t)b * T * DM; const int* pb = pos + b * T;
        hipLaunchKernelGGL(k_rmsnorm, NV_G1(T), xb, DM, 0, S + O_XN, DM, 0, IN(2), T, 1, DM);
        gemm(S + O_XN, DM, IN(3), FH, S + O_G, FH, T, FH, DM, st); gemm(S + O_XN, DM, IN(4), FH, S + O_U, FH, T, FH, DM, st);
        hipLaunchKernelGGL(k_swiglu, NV_G1((size_t)T * FH), S + O_G, S + O_U, (size_t)T * FH);
        HOOK(1);
        gemm(S + O_G, FH, IN(5), DM, S + O_BR1, DM, T, DM, FH, st);
        hipLaunchKernelGGL(k_axpy, NV_G1((size_t)T * DM), xb, S + O_BR1, 0.5f, ob, (size_t)T * DM);
        HOOK(2);
        hipLaunchKernelGGL(k_rmsnorm, NV_G1(T), ob, DM, 0, S + O_XN, DM, 0, IN(6), T, 1, DM);
        gemm(S + O_XN, DM, IN(7), INW, S + O_PROJ, INW, T, INW, DM, st);
        HOOK(3);
        hipLaunchKernelGGL(k_rmsnorm, NV_G1(T), S + O_PROJ, INW, 0, S + O_QN, 192, 0, IN(8), T, 1, 192);
        gemm(S + O_QN, 192, IN(9), 768, S + O_Q1, 768, T, 768, 192, st);
        hipLaunchKernelGGL(k_mla_qprep, NV_G1(T * 8), S + O_Q1, S + O_QF, IN(12), IN(13), pb);
        hipLaunchKernelGGL(k_rmsnorm, NV_G1(T), S + O_PROJ + 192, INW, 0, S + O_KVN, 128, 0, IN(10), T, 1, 128);
        gemm(S + O_KVN, 128, IN(11), 1024, S + O_KV, 1024, T, 1024, 128, st);
        hipLaunchKernelGGL(k_mla_kprep, NV_G1(T * 8), S + O_KV, S + O_PROJ, S + O_KF, IN(14), IN(15), pb);
        hipLaunchKernelGGL(k_rmsnorm, NV_G1(T * 8), S + O_PROJ + 352, INW, 64, S + O_FQ, 512, 64, IN(16), T, 8, 64);
        hipLaunchKernelGGL(k_rmsnorm, NV_G1(T * 8), S + O_PROJ + 864, INW, 64, S + O_FK, 512, 64, IN(17), T, 8, 64);
        hipLaunchKernelGGL(k_cum, dim3(8), dim3(64), 0, st, S + O_PROJ, IN(18), S + O_CUM);
        HOOK(4);
        hipLaunchKernelGGL(k_attn<96>, dim3(T * 8 / 4), dim3(256), 0, st, S + O_QF, 768, 96, S + O_KF, 768, 96, S + O_KV + 64, 1024, 128, S + O_YM, (const float*)nullptr, 0.10206207261596575f);
        hipLaunchKernelGGL(k_attn<64>, dim3(T * 8 / 4), dim3(256), 0, st, S + O_FQ, 512, 64, S + O_FK, 512, 64, S + O_PROJ + 1376, INW, 64, S + O_YF, S + O_CUM, 0.125f);
        HOOK(5);
        gemm(S + O_YM, 512, IN(19), DM, S + O_BR1, DM, T, DM, 512, st);
        hipLaunchKernelGGL(k_gate, NV_G1((size_t)T * DM), S + O_BR1, S + O_PROJ, 1896, IN(21));
        gemm(S + O_YF, 512, IN(20), DM, S + O_BR2, DM, T, DM, 512, st);
        hipLaunchKernelGGL(k_gate, NV_G1((size_t)T * DM), S + O_BR2, S + O_PROJ, 2920, IN(21) + DM);
        hipLaunchKernelGGL(k_add, NV_G1((size_t)T * DM), S + O_BR1, S + O_BR2, (size_t)T * DM);
        HOOK(6);
        gemm(S + O_BR1, DM, IN(22), DM, S + O_BR2, DM, T, DM, DM, st);
        hipLaunchKernelGGL(k_axpy, NV_G1((size_t)T * DM), ob, S + O_BR2, 1.0f, ob, (size_t)T * DM);
        HOOK(7);
        hipLaunchKernelGGL(k_rmsnorm, NV_G1(T), ob, DM, 0, S + O_XN, DM, 0, IN(23), T, 1, DM);
        gemm(S + O_XN, DM, IN(24), FH, S + O_G, FH, T, FH, DM, st); gemm(S + O_XN, DM, IN(25), FH, S + O_U, FH, T, FH, DM, st);
        hipLaunchKernelGGL(k_swiglu, NV_G1((size_t)T * FH), S + O_G, S + O_U, (size_t)T * FH);
        HOOK(8);
        gemm(S + O_G, FH, IN(26), DM, S + O_BR1, DM, T, DM, FH, st);
        hipLaunchKernelGGL(k_axpy, NV_G1((size_t)T * DM), ob, S + O_BR1, 0.5f, ob, (size_t)T * DM);
        HOOK(9);
    }
#undef IN
#undef HOOK
}
#undef NV_G1
}
extern "C" void kernel_launch(void* const* d_in, const int* in_sizes, int n_in, void* d_out, int out_size, void* d_ws, size_t ws_size, hipStream_t stream) {
    (void)in_sizes; (void)n_in; (void)out_size; (void)ws_size;
    nv::forward(d_in, (float*)d_out, (float*)d_ws, stream, nullptr);
}
```

```cpp
#include <hip/hip_runtime.h>
#include <cstdint>
#include <cstdio>
constexpr size_t MiB = 1u << 20, KiB = 1u << 10;
constexpr size_t WS_CTL = 0, CTL_ZERO_BYTES = 64 * KiB;
constexpr size_t WS_SS0 = 1 * MiB, WS_SS1 = WS_SS0 + 256 * KiB, WS_SS2 = WS_SS1 + 256 * KiB, WS_SSQ = WS_SS2 + 256 * KiB, WS_SSKV = 2 * MiB, WS_LOGF = WS_SSKV + 256 * KiB;
constexpr size_t WS_PAR = 2 * MiB + 768 * KiB;
constexpr int PAR_FQG = 0, PAR_FKG = 64, PAR_KRG = 128, PAR_BF = 160, PAR_QNG = 192, PAR_QRG = 256, PAR_KNG = 320, PAR_BG = 1024, PAR_N = 3072;
constexpr size_t WS_CUM = 3 * MiB, WS_COS = 4 * MiB, WS_SIN = 5 * MiB, WS_KR = 6 * MiB;
constexpr size_t WS_WGU1 = 8 * MiB, WS_WD1 = 19 * MiB, WS_QLAT = 8 * MiB, WS_KVLAT = 16 * MiB, WS_KAUG = 20 * MiB;
constexpr size_t WS_WGU2 = 25 * MiB, WS_WD2 = 36 * MiB, WS_WIN = 42 * MiB, WS_WAB = 50 * MiB, WS_WO = 52 * MiB, WS_WQB = 54 * MiB, WS_WKVB = 54 * MiB + 512 * KiB;
constexpr size_t WS_XB = 56 * MiB, WS_VM = 72 * MiB;
constexpr size_t WS_H = 88 * MiB, WS_QM = 88 * MiB, WS_T1 = 88 * MiB, WS_MIXED = 88 * MiB  , WS_KM = 112 * MiB, WS_YCAT = 128 * MiB, WS_QF = 144 * MiB, WS_VF = 160 * MiB;
constexpr size_t WS_GATES = 176 * MiB, WS_X2B = 176 * MiB, WS_KF = 240 * MiB, WS_END = 256 * MiB;
#if defined(MK_PRB)
__device__ unsigned long long g_prb[8]; __device__ int g_prb_on;
#define PRB_T0() unsigned long long prb_t_ = __builtin_amdgcn_s_memrealtime()
#define PRB_RE() do { prb_t_ = __builtin_amdgcn_s_memrealtime(); } while (0)
#define PRB_ACC(i) do { const unsigned long long n_ = __builtin_amdgcn_s_memrealtime(); if (blockIdx.x == 0 && threadIdx.x == 0) g_prb[i] += n_ - prb_t_; prb_t_ = n_; } while (0)
#define PRB_ACC_IF(i) do { const unsigned long long n_ = __builtin_amdgcn_s_memrealtime(); if (blockIdx.x == 0 && threadIdx.x == 0 && g_prb_on) g_prb[i] += n_ - prb_t_; prb_t_ = n_; } while (0)
#else
#define PRB_T0() do { } while (0)
#define PRB_RE() do { } while (0)
#define PRB_ACC(i) do { } while (0)
#define PRB_ACC_IF(i) do { } while (0)
#endif
namespace pg8 {
#define PG8_LAS __attribute__((address_space(3)))
typedef unsigned short bf16_t;
typedef short bf16x8 __attribute__((ext_vector_type(8)));
typedef float f32x4 __attribute__((ext_vector_type(4)));
typedef unsigned u32x4 __attribute__((ext_vector_type(4)));
constexpr int BM = 256, BK = 64, HALF = 128, HTB = HALF * BK * 2  , STAGE_BYTES = 8 * HTB, NXCD = 8, WGM = 4;

__host__ __device__ __forceinline__ int lds_byte(int r, int c) { const int st = (r >> 4) * 2 + (c >> 5), rr = r & 15, cc = c & 31, ob = rr * 64 + cc * 2; return st * 1024 + (ob ^ (((ob >> 9) & 1) << 5)); }
__host__ __device__ __forceinline__ void stage_rc(int b, int& R, int& C) { const int st = b / 1024, sb = b % 1024, swz = sb ^ (((sb >> 9) & 1) << 5); R = (st >> 1) * 16 + swz / 64; C = (st & 1) * 32 + (swz % 64) / 2; }
__host__ __device__ __forceinline__ int perm32(int rho) { const int n = rho >> 4, i = rho & 15; return 8 * (i >> 2) + 4 * n + (i & 3); }

struct Unit { int pm, pn; };
struct Gemm { const bf16_t* A; const bf16_t* Bt; int M, N, K; };

struct StaticOrder {
    int nM, nN, nwg, G, c;
    __host__ __device__ void init(int M, int N, int G_, int c_) { nM = M / BM; nN = N / BM; nwg = nM * nN; G = G_; c = c_; }
    __host__ __device__ bool next(int i, Unit& u) const {
        const long L = (long)i * G + c; if (L >= nwg) return false;
        int wgid = (int)L; { const int q = nwg / NXCD, r = nwg % NXCD, xcd = wgid % NXCD, off = wgid / NXCD; wgid = (xcd < r ? xcd * (q + 1) : r * (q + 1) + (xcd - r) * q) + off; }
        const int nig = WGM * nN, gid = wgid / nig, fm = gid * WGM, gsz = (nM - fm) < WGM ? (nM - fm) : WGM;
        u.pm = fm + ((wgid % nig) % gsz); u.pn = (wgid % nig) / gsz; return true;
    }
    __device__ __forceinline__ void a_ready(const Unit&) const {}
    __device__ __forceinline__ void done(const Unit&) const {}
};

typedef float f32x2_cv __attribute__((ext_vector_type(2))); typedef __bf16 bf16x2_cv __attribute__((ext_vector_type(2)));
__device__ __forceinline__ unsigned cvt_pk_bf16(float lo, float hi) { f32x2_cv v = {lo, hi}; bf16x2_cv b = __builtin_convertvector(v, bf16x2_cv); return __builtin_bit_cast(unsigned, b); }
typedef float f32x2 __attribute__((ext_vector_type(2)));
constexpr float RMS_EPS = 1e-6f;
constexpr float LOG2E = 1.4426950408889634f;
constexpr float C2F = 0.125f * 1.4426950408889634f;
constexpr float C2M = 0.10206207261596575f * 1.4426950408889634f;
__device__ __forceinline__ u32x4 pack8(f32x4 a, f32x4 b) { u32x4 w; w.x = cvt_pk_bf16(a[0], a[1]); w.y = cvt_pk_bf16(a[2], a[3]); w.z = cvt_pk_bf16(b[0], b[1]); w.w = cvt_pk_bf16(b[2], b[3]); return w; }
__device__ __forceinline__ void unpack8(u32x4 w, f32x4& a, f32x4& b) {
    a[0] = __uint_as_float(w.x << 16); a[1] = __uint_as_float(w.x & 0xffff0000u); a[2] = __uint_as_float(w.y << 16); a[3] = __uint_as_float(w.y & 0xffff0000u);
    b[0] = __uint_as_float(w.z << 16); b[1] = __uint_as_float(w.z & 0xffff0000u); b[2] = __uint_as_float(w.w << 16); b[3] = __uint_as_float(w.w & 0xffff0000u); }
__device__ __forceinline__ float rstd4(const float* ss, int row, float invn) { const f32x4 s = *(const f32x4*)(ss + 4 * (size_t)row); return __builtin_amdgcn_rsqf(((s[0] + s[1]) + (s[2] + s[3])) * invn + RMS_EPS); }
__device__ __forceinline__ float dot4(f32x4 a) { return (a[0] * a[0] + a[1] * a[1]) + (a[2] * a[2] + a[3] * a[3]); }
__device__ __forceinline__ float sig1(float z) { return __builtin_amdgcn_rcpf(1.0f + __builtin_amdgcn_exp2f(-LOG2E * z)); }
__device__ __forceinline__ f32x4 sig4(f32x4 z) { f32x4 r; r[0] = sig1(z[0]); r[1] = sig1(z[1]); r[2] = sig1(z[2]); r[3] = sig1(z[3]); return r; }
__device__ __forceinline__ float logsig1(float z) { const float t = __builtin_amdgcn_logf(1.0f + __builtin_amdgcn_exp2f(-LOG2E * fabsf(z))) * 0.6931471805599453f; return (z >= 0.f ? 0.f : z) - t; }
__device__ __forceinline__ float red_fq(float v) { v += __shfl_xor(v, 16); v += __shfl_xor(v, 32); return v; }

#define RSTD8(rs, ssp, row0, invn) float rs[8]; { f32x4 s8_[8]; _Pragma("unroll") for (int i8_ = 0; i8_ < 8; ++i8_) s8_[i8_] = *(const f32x4*)((ssp) + 4 * (size_t)((row0) + (i8_ >> 2) * HALF + (i8_ & 3) * 16)); \
    _Pragma("unroll") for (int i8_ = 0; i8_ < 8; ++i8_) rs[i8_] = __builtin_amdgcn_rsqf(((s8_[i8_][0] + s8_[i8_][1]) + (s8_[i8_][2] + s8_[i8_][3])) * (invn) + RMS_EPS); }
#define EPI_PIN(fr, fq) asm volatile("" : "+v"(fr), "+v"(fq))
struct EpiSwiglu {
    static constexpr bool PERM = true, AFTER_DRAIN = false;
    bf16_t* H; const float* ss; int ldh;
    __device__ __forceinline__ void operator()(const f32x4 (&acc)[2][2][4][2], const Unit& u, int wr, int wc, int fr, int fq) const {
        EPI_PIN(fr, fq);
        const int row0 = u.pm * BM + wr * 64 + fr, col0 = u.pn * 128 + wc * 32 + 8 * fq;
        RSTD8(rs8, ss, row0, 1.0f / 1024.0f);
#pragma unroll
        for (int ai = 0; ai < 2; ++ai)
#pragma unroll
            for (int m = 0; m < 4; ++m) { const int row = row0 + ai * HALF + m * 16; const float rs = rs8[ai * 4 + m];
                f32x4 h[2];
#pragma unroll
                for (int n = 0; n < 2; ++n) { const f32x4 g = acc[ai][0][m][n] * rs, up = acc[ai][1][m][n] * rs; h[n] = g * sig4(g) * up; }
                *(u32x4*)(H + (size_t)row * ldh + col0) = pack8(h[0], h[1]); }
    }
};
template <bool HALF_ALPHA, bool BASE_BF16, bool OUT_AUX>
struct EpiResid {
    static constexpr bool PERM = true, AFTER_DRAIN = true;
    const void* base; float* out; bf16_t* xb; float* ss;
    __device__ __forceinline__ void fused(f32x4 (&acc)[2][2][4][2], const Unit& u, int wr, int wc, int fr, int fq, PG8_LAS unsigned char* lds, int wid, int lane) const {
        EPI_PIN(fr, fq); constexpr float alpha = HALF_ALPHA ? 0.5f : 1.0f;
        PG8_LAS float* P = (PG8_LAS float*)lds;
        const int col0 = u.pn * BM + wc * 32 + 8 * fq;
        u32x4 bv[2][4][2];
        if (BASE_BF16) {
#pragma unroll
            for (int ai = 0; ai < 2; ++ai)
#pragma unroll
                for (int m = 0; m < 4; ++m) { const size_t off = (size_t)(u.pm * BM + ai * HALF + wr * 64 + m * 16 + fr) * 1024 + col0;
#pragma unroll
                    for (int bj = 0; bj < 2; ++bj) bv[ai][m][bj] = *(const u32x4*)((const bf16_t*)base + off + bj * HALF); } }
#pragma unroll
        for (int ai = 0; ai < 2; ++ai)
#pragma unroll
            for (int m = 0; m < 4; ++m) { const int r = ai * HALF + wr * 64 + m * 16 + fr; const size_t off = (size_t)(u.pm * BM + r) * 1024 + col0; float q = 0.f;
#pragma unroll
                for (int bj = 0; bj < 2; ++bj) { const size_t c = off + bj * HALF; f32x4 b0, b1;
                    if (BASE_BF16) unpack8(bv[ai][m][bj], b0, b1); else { b0 = *(const f32x4*)((const float*)base + c); b1 = *(const f32x4*)((const float*)base + c + 4); }
                    const f32x4 o0 = b0 + acc[ai][bj][m][0] * alpha, o1 = b1 + acc[ai][bj][m][1] * alpha;
                    if (OUT_AUX) { q += dot4(o0) + dot4(o1); *(u32x4*)(xb + c) = pack8(o0, o1); } else { *(f32x4*)(out + c) = o0; *(f32x4*)(out + c + 4) = o1; } }
                if (OUT_AUX) { q = red_fq(q); if (fq == 0) P[r * 4 + wc] = q; }
                if (!BASE_BF16 && (m & 1)) asm volatile("" ::: "memory"); }
        if (OUT_AUX) { asm volatile("s_waitcnt lgkmcnt(0)" ::: "memory"); __builtin_amdgcn_s_barrier(); asm volatile("" ::: "memory");
            const int t = wid * 64 + lane;
            if (t < 256) { const f32x4 p = *(const PG8_LAS f32x4*)(P + t * 4); ss[(size_t)(u.pm * BM + t) * 4 + u.pn] = (p[0] + p[1]) + (p[2] + p[3]); } }
    }
};
__device__ __forceinline__ void head_norm_store(const f32x4 (&v)[2][2], const f32x4 (&g)[2][2], float scale, bf16_t* dstrow) {
    float s = (dot4(v[0][0]) + dot4(v[0][1])) + (dot4(v[1][0]) + dot4(v[1][1])); s = red_fq(s);
    const float r2 = __builtin_amdgcn_rsqf(s * (1.0f / 64.0f) + RMS_EPS) * scale;
#pragma unroll
    for (int bj = 0; bj < 2; ++bj) *(u32x4*)(dstrow + 32 * bj) = pack8(v[bj][0] * r2 * g[bj][0], v[bj][1] * r2 * g[bj][1]);
}
__device__ __forceinline__ void rope_norm_store(f32x4 x1, f32x4 x2, f32x4 g1, f32x4 g2, const float* cosr, const float* sinr, int fq, float scale, bf16_t* dst8) {
    float s = dot4(x1) + dot4(x2); s = red_fq(s);
    const float r2 = __builtin_amdgcn_rsqf(s * (1.0f / 32.0f) + RMS_EPS);
    const f32x4 cs = *(const f32x4*)(cosr + 4 * fq), sn = *(const f32x4*)(sinr + 4 * fq);
    x1 = x1 * r2 * g1; x2 = x2 * r2 * g2;
    const f32x4 o1 = (x1 * cs - x2 * sn) * scale, o2 = (x2 * cs + x1 * sn) * scale;
    *(u32x4*)dst8 = pack8(o1, o2);
}
struct EpiWin {
    static constexpr bool PERM = true, AFTER_DRAIN = false;
    unsigned char* ws;
    __device__ __forceinline__ void operator()(const f32x4 (&acc)[2][2][4][2], const Unit& u, int wr, int wc, int fr, int fq) const {
        EPI_PIN(fr, fq);
        const float* ss1 = (const float*)(ws + WS_SS1); const float* par = (const float*)(ws + WS_PAR);
        bf16_t* qlat = (bf16_t*)(ws + WS_QLAT); bf16_t* kvlat = (bf16_t*)(ws + WS_KVLAT); bf16_t* kr = (bf16_t*)(ws + WS_KR);
        float* ssq = (float*)(ws + WS_SSQ); float* sskv = (float*)(ws + WS_SSKV); float* logf = (float*)(ws + WS_LOGF);
        const float* cosT = (const float*)(ws + WS_COS); const float* sinT = (const float*)(ws + WS_SIN);
        const float* krg = par + PAR_KRG; const float* bfp = par + PAR_BF; const float* bg = par + PAR_BG;
        const int row0 = u.pm * BM + wr * 64 + fr, pn = u.pn;
        RSTD8(rs8, ss1, row0, 1.0f / 1024.0f);
        if (pn == 0) {
#pragma unroll
            for (int ai = 0; ai < 2; ++ai)
#pragma unroll
                for (int m = 0; m < 4; ++m) { const int row = row0 + ai * HALF + m * 16; const float rs = rs8[ai * 4 + m]; float q = 0.f;
#pragma unroll
                    for (int bj = 0; bj < 2; ++bj) { const f32x4 a = acc[ai][bj][m][0] * rs, b = acc[ai][bj][m][1] * rs; q += dot4(a) + dot4(b);
                        *(u32x4*)(qlat + (size_t)row * 256 + bj * HALF + wc * 32 + 8 * fq) = pack8(a, b); }
                    q = red_fq(q); if (fq == 0) ssq[(size_t)row * 4 + wc] = q; }
        } else if (pn == 1) {
            const f32x4 g1 = *(const f32x4*)(krg + 4 * fq), g2 = *(const f32x4*)(krg + 16 + 4 * fq);
            const f32x4 b0 = *(const f32x4*)(bfp), b1 = *(const f32x4*)(bfp + 4);
#pragma unroll
            for (int ai = 0; ai < 2; ++ai)
#pragma unroll
                for (int m = 0; m < 4; ++m) { const int row = row0 + ai * HALF + m * 16; const float rs = rs8[ai * 4 + m];
                    const f32x4 a = acc[ai][0][m][0] * rs, b = acc[ai][0][m][1] * rs; float q = dot4(a) + dot4(b);
                    *(u32x4*)(kvlat + (size_t)row * 128 + wc * 32 + 8 * fq) = pack8(a, b);
                    q = red_fq(q); if (fq == 0) sskv[(size_t)row * 4 + wc] = q;
                    if (wc == 0) rope_norm_store(acc[ai][1][m][0] * rs, acc[ai][1][m][1] * rs, g1, g2, cosT + (size_t)row * 16, sinT + (size_t)row * 16, fq, 1.0f, kr + (size_t)row * 32 + 8 * fq);
                    if (wc == 1 && fq == 0) { const f32x4 z0 = acc[ai][1][m][0] * rs + b0, z1 = acc[ai][1][m][1] * rs + b1; f32x4 l0, l1;
#pragma unroll
                        for (int i = 0; i < 4; ++i) { l0[i] = logsig1(z0[i]); l1[i] = logsig1(z1[i]); }
                        *(f32x4*)(logf + (size_t)row * 8) = l0; *(f32x4*)(logf + (size_t)row * 8 + 4) = l1; } }
        } else if (pn < 8) {
            const int kind = (pn - 2) >> 1, head = 4 * ((pn - 2) & 1) + wc;
            bf16_t* dst = (bf16_t*)(ws + (kind == 0 ? WS_QF : kind == 1 ? WS_KF : WS_VF)) + 64 * head + 8 * fq;
            const float* gp = par + (kind == 1 ? PAR_FKG : PAR_FQG) + 8 * fq; f32x4 g[2][2];
#pragma unroll
            for (int bj = 0; bj < 2; ++bj)
#pragma unroll
                for (int n = 0; n < 2; ++n) g[bj][n] = *(const f32x4*)(gp + 32 * bj + 4 * n);
            const float scale = kind == 0 ? C2F : 1.0f;
#pragma unroll
            for (int ai = 0; ai < 2; ++ai)
#pragma unroll
                for (int m = 0; m < 4; ++m) { const int row = row0 + ai * HALF + m * 16; const float rs = rs8[ai * 4 + m]; f32x4 v[2][2];
#pragma unroll
                    for (int bj = 0; bj < 2; ++bj)
#pragma unroll
                        for (int n = 0; n < 2; ++n) v[bj][n] = acc[ai][bj][m][n] * rs;
                    if (kind == 2) {
#pragma unroll
                        for (int bj = 0; bj < 2; ++bj) *(u32x4*)(dst + (size_t)row * 512 + 32 * bj) = pack8(v[bj][0], v[bj][1]);
                    } else head_norm_store(v, g, scale, dst + (size_t)row * 512); }
        } else {
            const int which = (pn - 8) >> 2, colb = 256 * ((pn - 8) & 3) + wc * 32 + 8 * fq; f32x4 bb[2][2];
#pragma unroll
            for (int bj = 0; bj < 2; ++bj)
#pragma unroll
                for (int n = 0; n < 2; ++n) bb[bj][n] = *(const f32x4*)(bg + 1024 * which + colb + bj * HALF + 4 * n);
            bf16_t* dst = (bf16_t*)(ws + WS_GATES) + (size_t)which * 16384 * 1024 + colb;
#pragma unroll
            for (int ai = 0; ai < 2; ++ai)
#pragma unroll
                for (int m = 0; m < 4; ++m) { const int row = row0 + ai * HALF + m * 16; const float rs = rs8[ai * 4 + m];
#pragma unroll
                    for (int bj = 0; bj < 2; ++bj) *(u32x4*)(dst + (size_t)row * 1024 + bj * HALF) = pack8(sig4(acc[ai][bj][m][0] * rs + bb[bj][0]), sig4(acc[ai][bj][m][1] * rs + bb[bj][1])); }
        }
    }
};
struct EpiMlaQ {
    static constexpr bool PERM = true, AFTER_DRAIN = false;
    unsigned char* ws;
    __device__ __forceinline__ void operator()(const f32x4 (&acc)[2][2][4][2], const Unit& u, int wr, int wc, int fr, int fq) const {
        EPI_PIN(fr, fq);
        const float* ssq = (const float*)(ws + WS_SSQ); bf16_t* Qm = (bf16_t*)(ws + WS_QM); const float* gn = (const float*)(ws + WS_PAR) + PAR_QNG; const float* gr = (const float*)(ws + WS_PAR) + PAR_QRG;
        const float* cosT = (const float*)(ws + WS_COS); const float* sinT = (const float*)(ws + WS_SIN);
        const int row0 = u.pm * BM + wr * 64 + fr, pn = u.pn;
        RSTD8(rs8, ssq, row0, 1.0f / 192.0f);
        if (pn < 2) { const int head = 4 * pn + wc; f32x4 g[2][2];
#pragma unroll
            for (int bj = 0; bj < 2; ++bj)
#pragma unroll
                for (int n = 0; n < 2; ++n) g[bj][n] = *(const f32x4*)(gn + 8 * fq + 32 * bj + 4 * n);
#pragma unroll
            for (int ai = 0; ai < 2; ++ai)
#pragma unroll
                for (int m = 0; m < 4; ++m) { const int row = row0 + ai * HALF + m * 16; const float rs = rs8[ai * 4 + m]; f32x4 v[2][2];
#pragma unroll
                    for (int bj = 0; bj < 2; ++bj)
#pragma unroll
                        for (int n = 0; n < 2; ++n) v[bj][n] = acc[ai][bj][m][n] * rs;
                    head_norm_store(v, g, C2M, Qm + (size_t)row * 768 + 96 * head + 8 * fq); }
        } else { const f32x4 g1 = *(const f32x4*)(gr + 4 * fq), g2 = *(const f32x4*)(gr + 16 + 4 * fq);
#pragma unroll
            for (int ai = 0; ai < 2; ++ai)
#pragma unroll
                for (int m = 0; m < 4; ++m) { const int row = row0 + ai * HALF + m * 16; const float rs = rs8[ai * 4 + m];
#pragma unroll
                    for (int bj = 0; bj < 2; ++bj) rope_norm_store(acc[ai][bj][m][0] * rs, acc[ai][bj][m][1] * rs, g1, g2, cosT + (size_t)row * 16, sinT + (size_t)row * 16, fq, C2M,
                                                                   Qm + (size_t)row * 768 + 96 * (wc + 4 * bj) + 64 + 8 * fq); }
        }
    }
};
struct EpiMlaKV {
    static constexpr bool PERM = true, AFTER_DRAIN = false;
    unsigned char* ws; bf16_t* Vm;
    __device__ __forceinline__ void operator()(const f32x4 (&acc)[2][2][4][2], const Unit& u, int wr, int wc, int fr, int fq) const {
        EPI_PIN(fr, fq);
        const float* sskv = (const float*)(ws + WS_SSKV); bf16_t* Km = (bf16_t*)(ws + WS_KM); const float* gn = (const float*)(ws + WS_PAR) + PAR_KNG;
        const int row0 = u.pm * BM + wr * 64 + fr, pn = u.pn, head = 4 * (pn & 1) + wc; f32x4 g[2][2];
        RSTD8(rs8, sskv, row0, 1.0f / 128.0f);
#pragma unroll
        for (int bj = 0; bj < 2; ++bj)
#pragma unroll
            for (int n = 0; n < 2; ++n) g[bj][n] = *(const f32x4*)(gn + 8 * fq + 32 * bj + 4 * n);
#pragma unroll
        for (int ai = 0; ai < 2; ++ai)
#pragma unroll
            for (int m = 0; m < 4; ++m) { const int row = row0 + ai * HALF + m * 16; const float rs = rs8[ai * 4 + m]; f32x4 v[2][2];
#pragma unroll
                for (int bj = 0; bj < 2; ++bj)
#pragma unroll
                    for (int n = 0; n < 2; ++n) v[bj][n] = acc[ai][bj][m][n] * rs;
                if (pn < 2) head_norm_store(v, g, 1.0f, Km + (size_t)row * 512 + 64 * head + 8 * fq);
                else {
#pragma unroll
                    for (int bj = 0; bj < 2; ++bj) *(u32x4*)(Vm + (size_t)row * 512 + 64 * head + 8 * fq + 32 * bj) = pack8(v[bj][0], v[bj][1]); } }
    }
};
struct EpiBranch {
    static constexpr bool PERM = true, AFTER_DRAIN = false, MIDHOOK = true;
    unsigned char* ws;
    __device__ __forceinline__ bool mid(f32x4 (&acc)[2][2][4][2], const Unit& u, int wr, int wc, int fr, int fq) const {
        EPI_PIN(fr, fq);
        const bf16_t* gm = (const bf16_t*)(ws + WS_GATES); const bf16_t* gf = gm + (size_t)16384 * 1024; bf16_t* mixed = (bf16_t*)(ws + WS_MIXED);
        const int which = u.pm >= 64 ? 1 : 0, pm = u.pm - 64 * which, pn = u.pn - 4 * which;
        const int row0 = pm * BM + wr * 64 + fr, col0 = pn * BM + wc * 32 + 8 * fq;
        const f32x4 fl = (f32x4){1e-20f, 1e-20f, 1e-20f, 1e-20f};
        if (!which) {
#pragma unroll
            for (int ai = 0; ai < 2; ++ai)
#pragma unroll
                for (int m = 0; m < 4; ++m) { const size_t off = (size_t)(row0 + ai * HALF + m * 16) * 1024 + col0;
#pragma unroll
                    for (int bj = 0; bj < 2; ++bj) { f32x4 ma, mb, fa, fb; unpack8(*(const u32x4*)(gm + off + bj * HALF), ma, mb); unpack8(*(const u32x4*)(gf + off + bj * HALF), fa, fb);
#pragma unroll
                        for (int i = 0; i < 4; ++i) { acc[ai][bj][m][0][i] *= ma[i] * __builtin_amdgcn_rcpf(fmaxf(fa[i], fl[i])); acc[ai][bj][m][1][i] *= mb[i] * __builtin_amdgcn_rcpf(fmaxf(fb[i], fl[i])); } } }
            return true; }
#pragma unroll
        for (int ai = 0; ai < 2; ++ai)
#pragma unroll
            for (int m = 0; m < 4; ++m) { const size_t off = (size_t)(row0 + ai * HALF + m * 16) * 1024 + col0;
#pragma unroll
                for (int bj = 0; bj < 2; ++bj) { f32x4 fa, fb; unpack8(*(const u32x4*)(gf + off + bj * HALF), fa, fb);
                    f32x4 a = acc[ai][bj][m][0], b = acc[ai][bj][m][1];
#pragma unroll
                    for (int i = 0; i < 4; ++i) { a[i] *= fmaxf(fa[i], fl[i]); b[i] *= fmaxf(fb[i], fl[i]); }
                    *(u32x4*)(mixed + off + bj * HALF) = pack8(a, b); } }
        return false;
    }
};
struct BranchOrder {
    StaticOrder so;
    __device__ void init(int G_, int c_) { so.init(16384, 1024, G_, c_); }
    __device__ bool next(int i, Unit& u) const { Unit t; if (!so.next(i >> 1, t)) return false; const int which = i & 1; u.pm = t.pm + 64 * which; u.pn = t.pn + 4 * which; return true; }
    __device__ __forceinline__ void a_ready(const Unit&) const {}
    __device__ __forceinline__ void done(const Unit&) const {}
};
template <class T, class = void> struct epi_midhook { static constexpr bool value = false; };
template <class T> struct epi_midhook<T, decltype((void)T::MIDHOOK)> { static constexpr bool value = T::MIDHOOK; };
template <class Epi, class Sched, bool ALIGN_EPI = false, bool SP2 = false>
__device__ __forceinline__ void gemm_phase(PG8_LAS unsigned char* lds, const Gemm g, const Sched& S, const Epi& E) {
    const int tid = threadIdx.x, wid = __builtin_amdgcn_readfirstlane(tid >> 6), lane = tid & 63, wr = wid >> 2, wc = wid & 3, fr = lane & 15, fq = lane >> 4;
    const int K = g.K, nt = K / BK;
    unsigned voffA[2], voffB[2];
#pragma unroll
    for (int i = 0; i < 2; ++i) { int R, C; stage_rc(tid * 16 + i * 8192, R, C); const int Rb = Epi::PERM ? ((R & ~31) + perm32(R & 31)) : R;
        voffA[i] = (unsigned)(R * K + C) * 2u; voffB[i] = (unsigned)(Rb * K + C) * 2u; }
    const size_t kstep = (size_t)(BK * 2);
    const size_t hstep = (size_t)HALF * K * 2;
    const size_t tstep = 2 * hstep;
    const unsigned ldsw = (unsigned)wid * 1024u;
    const int aoff = lds_byte(wr * 64 + fr, fq * 8), boff = lds_byte(wc * 32 + fr, fq * 8);
#define PG8_SA(b, h) (((b) * 2 + (h)) * HTB)
#define PG8_SB(b, h) ((4 + (b) * 2 + (h)) * HTB)
#define PG8_STAGE(bufoff, gbase, voff) do { _Pragma("unroll") for (int _i = 0; _i < 2; ++_i) \
        __builtin_amdgcn_global_load_lds((const unsigned*)((const char*)(gbase) + (voff)[_i]), (PG8_LAS unsigned*)(lds + (bufoff) + ldsw + _i * 8192), 16, 0, 0); } while (0)
#define PG8_LDA(dst, b, h) do { _Pragma("unroll") for (int m = 0; m < 4; ++m) _Pragma("unroll") for (int k = 0; k < 2; ++k) dst[m][k] = *(const PG8_LAS bf16x8*)(lds + PG8_SA(b, h) + aoff + m * 2048 + k * 1024); } while (0)
#define PG8_LDB(dst, b, h) do { _Pragma("unroll") for (int n = 0; n < 2; ++n) _Pragma("unroll") for (int k = 0; k < 2; ++k) dst[n][k] = *(const PG8_LAS bf16x8*)(lds + PG8_SB(b, h) + boff + n * 2048 + k * 1024); } while (0)
#define PG8_MMA(ai, bj, At, Bt) do { __builtin_amdgcn_s_setprio(1); _Pragma("unroll") for (int m = 0; m < 4; ++m) _Pragma("unroll") for (int n = 0; n < 2; ++n) _Pragma("unroll") for (int k = 0; k < 2; ++k) \
        acc[ai][bj][m][n] = __builtin_amdgcn_mfma_f32_16x16x32_bf16(Bt[n][k], At[m][k], acc[ai][bj][m][n], 0, 0, 0); __builtin_amdgcn_s_setprio(0); } while (0)
#define PG8_WAIT_V(n) asm volatile("s_waitcnt vmcnt(" #n ")" ::: "memory")
#define PG8_WAIT_L(n) asm volatile("s_waitcnt lgkmcnt(" #n ")" ::: "memory")
#define PG8_BAR __builtin_amdgcn_s_barrier()
#define PG8_SCHED __builtin_amdgcn_sched_barrier(0)
    Unit cur, nxt; int ui = 0;
    if (!S.next(0, cur)) return;
    f32x4 acc[2][2][4][2];
#pragma unroll
    for (int a = 0; a < 2; ++a)
#pragma unroll
        for (int b = 0; b < 2; ++b)
#pragma unroll
            for (int m = 0; m < 4; ++m)
#pragma unroll
                for (int n = 0; n < 2; ++n) acc[a][b][m][n] = (f32x4){0.f, 0.f, 0.f, 0.f};
    bf16x8 At[4][2], B0[2][2], B1[2][2];
    const char* cA = (const char*)g.A + (size_t)cur.pm * tstep; const char* cB = (const char*)g.Bt + (size_t)cur.pn * tstep;
    S.a_ready(cur);
    if constexpr (SP2) {
        PG8_STAGE(PG8_SB(0, 0), cB, voffB); PG8_STAGE(PG8_SB(0, 1), cB + hstep, voffB); PG8_STAGE(PG8_SA(0, 0), cA, voffA); PG8_STAGE(PG8_SA(0, 1), cA + hstep, voffA);
        if (wr == 1) PG8_BAR;
        PG8_WAIT_V(2); PG8_BAR;
        PG8_STAGE(PG8_SB(1, 0), cB + kstep, voffB); PG8_STAGE(PG8_SA(1, 0), cA + kstep, voffA); PG8_STAGE(PG8_SB(1, 1), cB + hstep + kstep, voffB);
        PG8_WAIT_V(6); PG8_BAR;
    } else {
        PG8_STAGE(PG8_SB(0, 0), cB, voffB); PG8_STAGE(PG8_SA(0, 0), cA, voffA); PG8_STAGE(PG8_SB(0, 1), cB + hstep, voffB); PG8_STAGE(PG8_SA(0, 1), cA + hstep, voffA);
        if (wr == 1) PG8_BAR;
        PG8_WAIT_V(4); PG8_BAR;
        PG8_STAGE(PG8_SB(1, 0), cB + kstep, voffB); PG8_STAGE(PG8_SA(1, 0), cA + kstep, voffA); PG8_STAGE(PG8_SB(1, 1), cB + hstep + kstep, voffB);
        PG8_WAIT_V(6); PG8_BAR;
    }
    PRB_T0();
    for (;;) {
        const bool has_next = S.next(ui + 1, nxt);
        const char* nA = has_next ? (const char*)g.A + (size_t)nxt.pm * tstep : cA; const char* nB = has_next ? (const char*)g.Bt + (size_t)nxt.pn * tstep : cB;
        for (int t = 0; t < nt; t += 2) {
            const bool last = (t == nt - 2);
            const char* a1 = cA + (size_t)(t + 1) * kstep;
            const char* a2 = last ? nA : cA + (size_t)(t + 2) * kstep; const char* b2 = last ? nB : cB + (size_t)(t + 2) * kstep;
            const char* a3 = a2 + kstep; const char* b3 = b2 + kstep;
            if (last && has_next) S.a_ready(nxt);
            if constexpr (SP2) {
            PG8_LDB(B0, 0, 0); PG8_LDB(B1, 0, 1); PG8_SCHED; PG8_LDA(At, 0, 0); PG8_STAGE(PG8_SA(1, 1), a1 + hstep, voffA);
            PG8_WAIT_V(8); PG8_WAIT_L(0); PG8_BAR; PG8_MMA(0, 0, At, B0); PG8_MMA(0, 1, At, B1); PG8_BAR; PG8_SCHED;
            PG8_LDA(At, 0, 1); PG8_STAGE(PG8_SB(0, 0), b2, voffB); PG8_STAGE(PG8_SB(0, 1), b2 + hstep, voffB); PG8_STAGE(PG8_SA(0, 0), a2, voffA);
            PG8_WAIT_V(8); PG8_WAIT_L(0); PG8_BAR; PG8_MMA(1, 0, At, B0); PG8_MMA(1, 1, At, B1); PG8_BAR; PG8_SCHED;
            PG8_LDB(B0, 1, 0); PG8_LDB(B1, 1, 1); PG8_SCHED; PG8_LDA(At, 1, 0); PG8_STAGE(PG8_SA(0, 1), a2 + hstep, voffA);
            PG8_WAIT_V(8); PG8_WAIT_L(0); PG8_BAR; PG8_MMA(0, 0, At, B0); PG8_MMA(0, 1, At, B1); PG8_BAR; PG8_SCHED;
            PG8_LDA(At, 1, 1); PG8_STAGE(PG8_SB(1, 0), b3, voffB); PG8_STAGE(PG8_SB(1, 1), b3 + hstep, voffB); PG8_STAGE(PG8_SA(1, 0), a3, voffA);
            PG8_WAIT_V(8); PG8_WAIT_L(0); PG8_BAR; PG8_MMA(1, 0, At, B0); PG8_MMA(1, 1, At, B1); PG8_BAR; PG8_SCHED;
            } else {
            PG8_LDB(B0, 0, 0); PG8_SCHED; PG8_LDA(At, 0, 0); PG8_STAGE(PG8_SA(1, 1), a1 + hstep, voffA);
            PG8_WAIT_L(8); PG8_BAR; PG8_WAIT_L(0); PG8_MMA(0, 0, At, B0); PG8_BAR; PG8_SCHED;
            PG8_LDB(B1, 0, 1); PG8_STAGE(PG8_SB(0, 0), b2, voffB);
            PG8_BAR; PG8_WAIT_L(0); PG8_MMA(0, 1, At, B1); PG8_BAR;
            PG8_LDA(At, 0, 1); PG8_STAGE(PG8_SA(0, 0), a2, voffA);
            PG8_BAR; PG8_WAIT_L(0); PG8_MMA(1, 0, At, B0); PG8_BAR; PG8_SCHED;
            PG8_STAGE(PG8_SB(0, 1), b2 + hstep, voffB);
            PG8_WAIT_V(6); PG8_BAR; PG8_MMA(1, 1, At, B1); PG8_BAR;
            PG8_LDB(B0, 1, 0); PG8_SCHED; PG8_LDA(At, 1, 0); PG8_STAGE(PG8_SA(0, 1), a2 + hstep, voffA);
            PG8_WAIT_L(8); PG8_BAR; PG8_WAIT_L(0); PG8_MMA(0, 0, At, B0); PG8_BAR; PG8_SCHED;
            PG8_LDB(B1, 1, 1); PG8_STAGE(PG8_SB(1, 0), b3, voffB);
            PG8_BAR; PG8_WAIT_L(0); PG8_MMA(0, 1, At, B1); PG8_BAR;
            PG8_LDA(At, 1, 1); PG8_STAGE(PG8_SA(1, 0), a3, voffA);
            PG8_BAR; PG8_WAIT_L(0); PG8_MMA(1, 0, At, B0); PG8_BAR; PG8_SCHED;
            PG8_STAGE(PG8_SB(1, 1), b3 + hstep, voffB);
            PG8_WAIT_V(6); PG8_BAR; PG8_MMA(1, 1, At, B1); PG8_BAR;
            }
        }
        if constexpr (ALIGN_EPI) { if (wr == 0) PG8_BAR; }
        bool keep_acc = false;
        PRB_ACC_IF(4); if constexpr (!Epi::AFTER_DRAIN) { if constexpr (epi_midhook<Epi>::value) keep_acc = E.mid(acc, cur, wr, wc, fr, fq); else E(acc, cur, wr, wc, fr, fq); S.done(cur); } PRB_ACC_IF(3);
        if (!has_next) break;
        if (!keep_acc)
#pragma unroll
        for (int a = 0; a < 2; ++a)
#pragma unroll
            for (int b = 0; b < 2; ++b)
#pragma unroll
                for (int m = 0; m < 4; ++m)
#pragma unroll
                    for (int n = 0; n < 2; ++n) acc[a][b][m][n] = (f32x4){0.f, 0.f, 0.f, 0.f};
        cur = nxt; cA = nA; cB = nB; ++ui;
        if constexpr (ALIGN_EPI) { if (wr == 1) PG8_BAR; }
    }
    PG8_WAIT_V(0);
    if constexpr (!ALIGN_EPI) { if (wr == 0) PG8_BAR; }
    PG8_BAR;
    PRB_ACC_IF(4); if constexpr (Epi::AFTER_DRAIN) { E.fused(acc, cur, wr, wc, fr, fq, lds, wid, lane); S.done(cur); } PRB_ACC_IF(3);
#undef PG8_SA
#undef PG8_SB
#undef PG8_STAGE
#undef PG8_LDA
#undef PG8_LDB
#undef PG8_MMA
#undef PG8_WAIT_V
#undef PG8_WAIT_L
#undef PG8_BAR
#undef PG8_SCHED
}
}
namespace att {
#define ALAS __attribute__((address_space(3)))
typedef short bf16x8 __attribute__((ext_vector_type(8)));
typedef short s16x4 __attribute__((ext_vector_type(4)));
typedef float f32x16 __attribute__((ext_vector_type(16)));
typedef float f32x4 __attribute__((ext_vector_type(4)));
typedef unsigned u32x4 __attribute__((ext_vector_type(4)));
typedef unsigned short bf16_t;
constexpr int SEQ = 4096, QB = 256, KVB = 64;
constexpr int L_K = 0, L_V = 49152, L_WS = 81920, L_OST = 83968, L_END = 116736;
constexpr float THR = 20.0f;
__device__ __forceinline__ int crow(int r, int hi) { return (r & 3) + 8 * (r >> 2) + 4 * hi; }
__device__ __forceinline__ unsigned cvtpk(float lo, float hi) { return pg8::cvt_pk_bf16(lo, hi); }
__device__ __forceinline__ float addf(float a, float b) { float r; asm("v_add_f32 %0, %1, %2" : "=v"(r) : "v"(a), "v"(b)); return r; }
__device__ __forceinline__ s16x4 vtr(const ALAS char* p) { typedef short v4i16_t __attribute__((ext_vector_type(4))); return __builtin_bit_cast(s16x4, __builtin_amdgcn_ds_read_tr16_b64_v4i16((ALAS v4i16_t*)p)); }

template <int NKS, bool QONE, int QP, int QH, int KP, int KXP, int KXH, int VP, int OP, int ABL = 0>
__device__ __forceinline__ void attn_unit(int b, int h, int qb, const bf16_t* Q, const bf16_t* K, const bf16_t* KX, const bf16_t* V, bf16_t* O, ALAS char* shm) {
    int tid = threadIdx.x; asm volatile("" : "+v"(tid));
    const int lane = tid & 63, r32 = lane & 31, hi = lane >> 5; const int wid = __builtin_amdgcn_readfirstlane(tid >> 6);
    const long tok0 = (long)b * SEQ; const int q0 = qb * QB, NT = (q0 + QB) / KVB;
    bf16x8 qr[NKS];
    { const bf16_t* Qw = Q + (tok0 + q0 + wid * 32 + r32) * QP + h * QH;
#pragma unroll
      for (int ks = 0; ks < (QONE ? NKS - 1 : NKS); ++ks) qr[ks] = *(const bf16x8*)(Qw + ks * 16 + hi * 8);
      if (QONE) { const short one = hi ? (short)0 : (short)0x3F80; qr[NKS - 1] = (bf16x8){one, one, one, 0, 0, 0, 0, 0}; } }
#define QPIN() do { _Pragma("unroll") for (int ks = 0; ks < NKS; ++ks) asm volatile("s_waitcnt vmcnt(0)" : "+v"(qr[ks]) :: "memory"); } while (0)
    const int kr1 = 4 * wid + (lane >> 4), kc = (lane & 15) ^ (kr1 & 15); const bool kact = kc < 2 * NKS;
    const bf16_t* ksrc = K + (tok0 + kr1) * KP + h * 64 + kc * 8; int kstep = KP;
    if (kc >= 8) { ksrc = KX + (tok0 + kr1) * KXP + h * KXH + (kc - 8) * 8; kstep = KXP; }
    const bf16_t* vsrc = V + (tok0 + 16 * (wid & 3) + (lane >> 2)) * VP + h * 64 + (wid >> 2) * 32 + (lane & 3) * 8;
    const unsigned lds0 = (unsigned)(uintptr_t)shm;
    const unsigned kdst = lds0 + L_K + wid * 1024, vdst = lds0 + L_V + wid * 1024;
#define GLDS16(gp, dst) do { unsigned keep_; asm volatile("s_mov_b32 %0, m0\n\ts_mov_b32 m0, %2\n\ts_nop 0\n\tglobal_load_lds_dwordx4 %1, off\n\ts_mov_b32 m0, %0" : "=&s"(keep_) : "v"(gp), "s"((unsigned)__builtin_amdgcn_readfirstlane(dst)) : "memory"); } while (0)
    const bf16_t* kp_a = ksrc; const bf16_t* kp_b = ksrc + 32 * kstep; const bf16_t* vp_a = vsrc; const int kinc = 64 * kstep;
#define DMA_KA(ksl) do { if (kact) GLDS16(kp_a, kdst + (ksl) * 16384); kp_a += kinc; } while (0)
#define DMA_KB(ksl) do { if (kact) GLDS16(kp_b, kdst + (ksl) * 16384 + 8192); kp_b += kinc; } while (0)
#define DMA_V(vsl) do { GLDS16(vp_a, vdst + (vsl)); vp_a += 64 * VP; } while (0)
#define LOADT(t, ksl, vsl) do {   DMA_KA(ksl); DMA_KB(ksl); DMA_V(vsl); } while (0)
#define TILE_SYNC(inflight) do { if (inflight) asm volatile("s_waitcnt vmcnt(3) lgkmcnt(0)" ::: "memory"); else asm volatile("s_waitcnt vmcnt(0) lgkmcnt(0)" ::: "memory"); PRB_ACC(1); \
        __builtin_amdgcn_s_barrier(); asm volatile("" ::: "memory"); } while (0)
    int kra[NKS];
#pragma unroll
    for (int ks = 0; ks < NKS; ++ks) kra[ks] = L_K + r32 * 256 + (((2 * ks + hi) ^ (r32 & 15)) << 4);
    const int vrb = L_V + ((lane >> 4) & 1) * 32 + (lane & 3) * 8 + (4 * hi + ((lane & 15) >> 2)) * 64;
    ALAS float* wsf = (ALAS float*)(shm + L_WS) + wid * 64;
    const int qrel = wid * 32 + r32;
    float zf_ = 0.f; asm volatile("" : "+v"(zf_));
    float m_run = 0.f, l_run = 0.f; f32x16 o[2], negm;
#pragma unroll
    for (int r = 0; r < 16; ++r) { o[0][r] = zf_; o[1][r] = zf_; negm[r] = zf_; }
    asm volatile("" : "+v"(negm));
    f32x16 p0, p1; bf16x8 vf[8]; u32x4 pw[4];
#define ACT(t) (((t) < NT - 4) || (64 * ((t) - (NT - 4)) <= 32 * wid + 31))
#define SB() __builtin_amdgcn_sched_barrier(0)
#define SMH(P, PEND, HAS_PEND, HALFI, FIRST) do { \
        float a_ = fmaxf(fmaxf(P[0], P[1]), P[2]), b_ = fmaxf(fmaxf(P[3], P[4]), P[5]); a_ = fmaxf(fmaxf(a_, P[6]), P[7]); b_ = fmaxf(fmaxf(b_, P[8]), P[9]); \
        a_ = fmaxf(fmaxf(a_, P[10]), P[11]); b_ = fmaxf(fmaxf(b_, P[12]), P[13]); a_ = fmaxf(fmaxf(a_, P[14]), P[15]); \
        float mx_ = fmaxf(a_, b_); { auto rr_ = __builtin_amdgcn_permlane32_swap(__float_as_uint(mx_), __float_as_uint(mx_), false, false); mx_ = fmaxf(__uint_as_float(rr_[0]), __uint_as_float(rr_[1])); } \
        const bool need_ = (FIRST) || (mx_ > THR); \
        if (__any(need_)) { const float dl_ = need_ ? mx_ : 0.f; m_run += dl_; const float al_ = __builtin_amdgcn_exp2f(-dl_); l_run *= al_; \
            _Pragma("unroll") for (int r = 0; r < 16; ++r) { P[r] -= dl_; if (HAS_PEND) PEND[r] -= dl_; negm[r] = -m_run; } asm volatile("" : "+v"(negm)); \
            if (hi == 0) wsf[r32] = al_; asm volatile("s_waitcnt lgkmcnt(0)" ::: "memory"); \
            _Pragma("unroll") for (int g = 0; g < 4; ++g) { const f32x4 av_ = *(const ALAS f32x4*)(wsf + 8 * g + 4 * hi); \
                _Pragma("unroll") for (int i = 0; i < 4; ++i) { o[0][4 * g + i] *= av_[i]; o[1][4 * g + i] *= av_[i]; } } } \
        if (ABL != 1 && ABL != 6) { _Pragma("unroll") for (int r = 0; r < 16; ++r) P[r] = __builtin_amdgcn_exp2f(P[r]); } \
        if (ABL != 1 && ABL != 6) { float s0_ = addf(P[0], P[1]), s1_ = addf(P[2], P[3]), s2_ = addf(P[4], P[5]), s3_ = addf(P[6], P[7]); s0_ = addf(s0_, addf(P[8], P[9])); s1_ = addf(s1_, addf(P[10], P[11])); s2_ = addf(s2_, addf(P[12], P[13])); s3_ = addf(s3_, addf(P[14], P[15])); l_run = addf(l_run, addf(addf(s0_, s1_), addf(s2_, s3_))); } \
        _Pragma("unroll") for (int s = 0; s < 2; ++s) pw[2 * (HALFI) + s] = (u32x4){cvtpk(P[8 * s], P[8 * s + 1]), cvtpk(P[8 * s + 2], P[8 * s + 3]), cvtpk(P[8 * s + 4], P[8 * s + 5]), cvtpk(P[8 * s + 6], P[8 * s + 7])}; } while (0)
#define PVH(HALFI) do { if (ABL == 2) { asm volatile("" :: "v"(pw[2 * (HALFI)]), "v"(pw[2 * (HALFI) + 1])); } else _Pragma("unroll") for (int ks = 2 * (HALFI); ks < 2 * (HALFI) + 2; ++ks) _Pragma("unroll") for (int d0 = 0; d0 < 2; ++d0) \
        o[d0] = __builtin_amdgcn_mfma_f32_32x32x16_bf16(__builtin_bit_cast(bf16x8, pw[ks]), vf[2 * ks + d0], o[d0], 0, 0, 0); } while (0)
#define TILE(t, ksl, vsl, DIAG, EMB, ksl2, vsl2) do { if (!(DIAG) || ACT(t)) { const ALAS char* kp_ = (const ALAS char*)shm + (ksl) * 16384; const ALAS char* vp_ = (const ALAS char*)shm + (vrb + (vsl)); \
        bf16x8 ka_[NKS], kb_[NKS]; \
        _Pragma("unroll") for (int ks = 0; ks < NKS; ++ks) ka_[ks] = *(const ALAS bf16x8*)(kp_ + kra[ks]); \
        _Pragma("unroll") for (int ks = 0; ks < NKS; ++ks) kb_[ks] = *(const ALAS bf16x8*)(kp_ + kra[ks] + 8192); \
        _Pragma("unroll") for (int ks = 0; ks < 4; ++ks) _Pragma("unroll") for (int d0 = 0; d0 < 2; ++d0) { const s16x4 lo_ = vtr(vp_ + d0 * 4096 + ks * 1024), hh_ = vtr(vp_ + d0 * 4096 + ks * 1024 + 512); \
            vf[2 * ks + d0] = (bf16x8){lo_[0], lo_[1], lo_[2], lo_[3], hh_[0], hh_[1], hh_[2], hh_[3]}; } \
        SB(); \
        p0 = __builtin_amdgcn_mfma_f32_32x32x16_bf16(ka_[0], qr[0], negm, 0, 0, 0); \
        p0 = __builtin_amdgcn_mfma_f32_32x32x16_bf16(ka_[1], qr[1], p0, 0, 0, 0); \
        if (EMB) { SB(); DMA_KA(ksl2); SB(); }     \
        _Pragma("unroll") for (int ks = 2; ks < NKS; ++ks) p0 = __builtin_amdgcn_mfma_f32_32x32x16_bf16(ka_[ks], qr[ks], p0, 0, 0, 0); \
        if (EMB) { SB(); DMA_KB(ksl2); SB(); } \
        p1 = __builtin_amdgcn_mfma_f32_32x32x16_bf16(kb_[0], qr[0], negm, 0, 0, 0); \
        p1 = __builtin_amdgcn_mfma_f32_32x32x16_bf16(kb_[1], qr[1], p1, 0, 0, 0); \
        p1 = __builtin_amdgcn_mfma_f32_32x32x16_bf16(kb_[2], qr[2], p1, 0, 0, 0); \
        if (EMB) { SB(); DMA_V(vsl2); SB(); } \
        _Pragma("unroll") for (int ks = 3; ks < NKS; ++ks) p1 = __builtin_amdgcn_mfma_f32_32x32x16_bf16(kb_[ks], qr[ks], p1, 0, 0, 0); \
        const int jb_ = (t) - (NT - 4); const bool dmask_ = (DIAG) && 64 * jb_ + 63 > 32 * wid; \
        if (dmask_) { const float NEG = -__builtin_inff(); const int kbm_ = 64 * jb_ + 4 * hi; \
            _Pragma("unroll") for (int r = 0; r < 16; ++r) { const int kv = kbm_ + (r & 3) + 8 * (r >> 2); if (kv > qrel) p0[r] = NEG; if (kv + 32 > qrel) p1[r] = NEG; } } \
        SMH(p0, p1, true, 0, (t) == 0); \
        PVH(0); \
        SMH(p1, p0, false, 1, false); \
        PVH(1); } } while (0)
#define ROT() do { ks_cur = ks_n1; ks_n1 = ks_n2; ks_n2 = (ks_n2 == 2) ? 0 : ks_n2 + 1; } while (0)
#define VS(t) (((t) & 3) * 8192)
    int ks_cur = 0, ks_n1 = 1, ks_n2 = 2;
    QPIN(); PRB_T0(); LOADT(0, 0, VS(0)); LOADT(1, 1, VS(1)); TILE_SYNC(true);
    int t = 0;
    for (; t < NT - 4; ++t) {
        PRB_RE(); TILE(t, ks_cur, VS(t), false, true, ks_n2, VS(t + 2)); PRB_ACC(0);
        TILE_SYNC(true); PRB_ACC(2); ROT();
    }
    for (; t < NT; ++t) {
        if (t + 2 < NT) LOADT(t + 2, ks_n2, VS(t + 2));
        PRB_RE(); TILE(t, ks_cur, VS(t), true, false, 0, 0); PRB_ACC(0);
        TILE_SYNC(t + 2 < NT); PRB_ACC(2); ROT();
    }
#undef VS
#undef QPIN
#undef LOADT
#undef DMA_KA
#undef DMA_KB
#undef DMA_V
#undef GLDS16
#undef TILE_SYNC
#undef ACT
#undef SB
#undef SMH
#undef PVH
#undef TILE
#undef ROT
    { auto rr = __builtin_amdgcn_permlane32_swap(__float_as_uint(l_run), __float_as_uint(l_run), false, false); l_run = __uint_as_float(rr[0]) + __uint_as_float(rr[1]); }
    if (hi == 0) wsf[32 + r32] = l_run; asm volatile("s_waitcnt lgkmcnt(0)" ::: "memory");
    float rli[16];
#pragma unroll
    for (int g = 0; g < 4; ++g) { const f32x4 a = *(const ALAS f32x4*)(wsf + 32 + 8 * g + 4 * hi);
#pragma unroll
        for (int i = 0; i < 4; ++i) rli[4 * g + i] = __builtin_amdgcn_rcpf(a[i]); }
    bf16_t* Ow = O + (tok0 + q0 + wid * 32) * OP + h * 64;
    { ALAS bf16_t* stg = (ALAS bf16_t*)(shm + L_OST) + wid * 2048;
#pragma unroll
      for (int r = 0; r < 16; ++r) { const int orow = crow(r, hi);
#pragma unroll
          for (int d0 = 0; d0 < 2; ++d0) stg[orow * 64 + d0 * 32 + r32] = (bf16_t)(cvtpk(o[d0][r] * rli[r], 0.f) & 0xffffu); }
      asm volatile("s_waitcnt lgkmcnt(0)" ::: "memory");
#pragma unroll
      for (int i = 0; i < 4; ++i) { const int row = i * 8 + (lane >> 3), ch = lane & 7; const u32x4 v = *(const ALAS u32x4*)(stg + row * 64 + ch * 8); *(u32x4*)(Ow + (long)row * OP + ch * 8) = v; } }
}
template <int NKS, bool QONE, int QP, int QH, int KP, int KXP, int KXH, int VP, int OP, int ABL9 = 0>
__device__ __forceinline__ void attn_unit9(int b, int h, int qb, const bf16_t* Q, const bf16_t* K, const bf16_t* KX, const bf16_t* V, bf16_t* O, ALAS char* shm) {
    int tid = threadIdx.x; asm volatile("" : "+v"(tid));
    const int lane = tid & 63, r32 = lane & 31, hi = lane >> 5; const int wid = __builtin_amdgcn_readfirstlane(tid >> 6);
    const long tok0 = (long)b * SEQ; const int q0 = qb * QB, NT = (q0 + QB) / KVB;
    bf16x8 qr[NKS];
    { const bf16_t* Qw = Q + (tok0 + q0 + wid * 32 + r32) * QP + h * QH;
#pragma unroll
      for (int ks = 0; ks < (QONE ? NKS - 1 : NKS); ++ks) qr[ks] = *(const bf16x8*)(Qw + ks * 16 + hi * 8);
      if (QONE) { const short one = hi ? (short)0 : (short)0x3F80; qr[NKS - 1] = (bf16x8){one, one, one, 0, 0, 0, 0, 0}; } }
#define QPIN() do { _Pragma("unroll") for (int ks = 0; ks < NKS; ++ks) asm volatile("s_waitcnt vmcnt(0)" : "+v"(qr[ks]) :: "memory"); } while (0)
    const int kr1 = 4 * wid + (lane >> 4), kc = (lane & 15) ^ (kr1 & 15); const bool kact = kc < 2 * NKS;
    const bf16_t* ksrc = K + (tok0 + kr1) * KP + h * 64 + kc * 8; int kstep = KP;
    if (kc >= 8) { ksrc = KX + (tok0 + kr1) * KXP + h * KXH + (kc - 8) * 8; kstep = KXP; }
    const bf16_t* vsrc = V + (tok0 + 16 * (wid & 3) + (lane >> 2)) * VP + h * 64 + (wid >> 2) * 32 + (lane & 3) * 8;
    const unsigned lds0 = (unsigned)(uintptr_t)shm;
    const unsigned kdst = lds0 + L_K + wid * 1024, vdst = lds0 + L_V + wid * 1024;
#define GLDS16(gp, dst) do { unsigned keep_; asm volatile("s_mov_b32 %0, m0\n\ts_mov_b32 m0, %2\n\ts_nop 0\n\tglobal_load_lds_dwordx4 %1, off\n\ts_mov_b32 m0, %0" : "=&s"(keep_) : "v"(gp), "s"((unsigned)__builtin_amdgcn_readfirstlane(dst)) : "memory"); } while (0)
    const bf16_t* kp_a = ksrc; const bf16_t* kp_b = ksrc + 32 * kstep; const bf16_t* vp_a = vsrc; const int kinc = 64 * kstep;
#define DMA_KA(ksl) do { if (kact) GLDS16(kp_a, kdst + (ksl) * 16384); kp_a += kinc; } while (0)
#define DMA_KB(ksl) do { if (kact) GLDS16(kp_b, kdst + (ksl) * 16384 + 8192); kp_b += kinc; } while (0)
#define DMA_V(vsl) do { GLDS16(vp_a, vdst + (vsl)); vp_a += 64 * VP; } while (0)
#define LOADT(t, ksl, vsl) do {   DMA_KA(ksl); DMA_KB(ksl); DMA_V(vsl); } while (0)
#define TILE_SYNC(inflight) do { if (inflight) asm volatile("s_waitcnt vmcnt(3) lgkmcnt(0)" ::: "memory"); else asm volatile("s_waitcnt vmcnt(0) lgkmcnt(0)" ::: "memory"); PRB_ACC(1); \
        __builtin_amdgcn_s_barrier(); asm volatile("" ::: "memory"); } while (0)
    int kra[NKS];
#pragma unroll
    for (int ks = 0; ks < NKS; ++ks) kra[ks] = L_K + r32 * 256 + (((2 * ks + hi) ^ (r32 & 15)) << 4);
    const int vrb = L_V + ((lane >> 4) & 1) * 32 + (lane & 3) * 8 + (4 * hi + ((lane & 15) >> 2)) * 64;
    ALAS float* wsf = (ALAS float*)(shm + L_WS) + wid * 64;
    const int qrel = wid * 32 + r32;
    float zf_ = 0.f; asm volatile("" : "+v"(zf_));
    float m_run = 0.f, l_run = 0.f; f32x16 o[2];
#pragma unroll
    for (int r = 0; r < 16; ++r) { o[0][r] = zf_; o[1][r] = zf_; }
    f32x16 pA0, pA1, pB0, pB1; u32x4 pw[4];
#define ACT(t) (((t) < NT - 4) || (64 * ((t) - (NT - 4)) <= 32 * wid + 31))
#define SB() __builtin_amdgcn_sched_barrier(0)
#define SGB(mask, n) __builtin_amdgcn_sched_group_barrier(mask, n, 0)
#define KFRAG(dst, rh, ksl) do { const ALAS char* kp_ = (const ALAS char*)shm + (ksl) * 16384 + (rh) * 8192; _Pragma("unroll") for (int ks = 0; ks < NKS; ++ks) dst[ks] = *(const ALAS bf16x8*)(kp_ + kra[ks]); } while (0)
#define QKCHAIN(P, kf) do { P = __builtin_amdgcn_mfma_f32_32x32x16_bf16(kf[0], qr[0], f32x16{}, 0, 0, 0); \
        _Pragma("unroll") for (int ks = 1; ks < NKS; ++ks) P = __builtin_amdgcn_mfma_f32_32x32x16_bf16(kf[ks], qr[ks], P, 0, 0, 0); } while (0)
#define MASK2(P0, P1, t) do { const int jb_ = (t) - (NT - 4); if (jb_ >= 0 && 64 * jb_ + 63 > 32 * wid) { const float NEG = -__builtin_inff(); const int kbm_ = 64 * jb_ + 4 * hi; \
        _Pragma("unroll") for (int r = 0; r < 16; ++r) { const int kv = kbm_ + (r & 3) + 8 * (r >> 2); if (kv > qrel) P0[r] = NEG; if (kv + 32 > qrel) P1[r] = NEG; } } } while (0)
#define DECIDE2(C0, C1, FIRST) do { \
        float a_ = fmaxf(fmaxf(C0[0], C0[1]), C1[0]), b_ = fmaxf(fmaxf(C0[2], C0[3]), C1[1]); a_ = fmaxf(fmaxf(a_, C1[2]), C1[3]); \
        _Pragma("unroll") for (int r = 4; r < 16; r += 4) { a_ = fmaxf(fmaxf(a_, C0[r]), C0[r + 1]); b_ = fmaxf(fmaxf(b_, C0[r + 2]), C0[r + 3]); a_ = fmaxf(fmaxf(a_, C1[r]), C1[r + 1]); b_ = fmaxf(fmaxf(b_, C1[r + 2]), C1[r + 3]); } \
        float mx_ = fmaxf(a_, b_); { auto rr_ = __builtin_amdgcn_permlane32_swap(__float_as_uint(mx_), __float_as_uint(mx_), false, false); mx_ = fmaxf(__uint_as_float(rr_[0]), __uint_as_float(rr_[1])); } \
        const bool need_ = (FIRST) || (mx_ > m_run + THR); \
        if (__any(need_)) { const float al_ = need_ ? __builtin_amdgcn_exp2f(m_run - mx_) : 1.0f; if (FIRST) l_run = 0.f; else l_run *= al_; m_run = need_ ? mx_ : m_run; \
            if (hi == 0) wsf[r32] = (FIRST) ? 1.0f : al_; asm volatile("s_waitcnt lgkmcnt(0)" ::: "memory"); \
            _Pragma("unroll") for (int g = 0; g < 4; ++g) { const f32x4 av_ = *(const ALAS f32x4*)(wsf + 8 * g + 4 * hi); \
                _Pragma("unroll") for (int i = 0; i < 4; ++i) { o[0][4 * g + i] *= av_[i]; o[1][4 * g + i] *= av_[i]; } } } } while (0)
#define EXPSUMPACK(C0, C1) do { _Pragma("unroll") for (int r = 0; r < 16; ++r) { C0[r] = __builtin_amdgcn_exp2f(C0[r] - m_run); C1[r] = __builtin_amdgcn_exp2f(C1[r] - m_run); } \
        float s0_ = addf(C0[0], C1[0]), s1_ = addf(C0[1], C1[1]), s2_ = addf(C0[2], C1[2]), s3_ = addf(C0[3], C1[3]); \
        _Pragma("unroll") for (int r = 4; r < 16; r += 4) { s0_ = addf(s0_, addf(C0[r], C1[r])); s1_ = addf(s1_, addf(C0[r + 1], C1[r + 1])); s2_ = addf(s2_, addf(C0[r + 2], C1[r + 2])); s3_ = addf(s3_, addf(C0[r + 3], C1[r + 3])); } \
        l_run = addf(l_run, addf(addf(s0_, s1_), addf(s2_, s3_))); \
        _Pragma("unroll") for (int s = 0; s < 2; ++s) { pw[s] = (u32x4){cvtpk(C0[8 * s], C0[8 * s + 1]), cvtpk(C0[8 * s + 2], C0[8 * s + 3]), cvtpk(C0[8 * s + 4], C0[8 * s + 5]), cvtpk(C0[8 * s + 6], C0[8 * s + 7])}; \
            pw[2 + s] = (u32x4){cvtpk(C1[8 * s], C1[8 * s + 1]), cvtpk(C1[8 * s + 2], C1[8 * s + 3]), cvtpk(C1[8 * s + 4], C1[8 * s + 5]), cvtpk(C1[8 * s + 6], C1[8 * s + 7])}; } } while (0)
#define PV8(vsl) do { const ALAS char* vp_ = (const ALAS char*)shm + (vrb + (vsl)); \
        _Pragma("unroll") for (int ks = 0; ks < 4; ++ks) _Pragma("unroll") for (int d0 = 0; d0 < 2; ++d0) { const s16x4 lo_ = vtr(vp_ + d0 * 4096 + ks * 1024), hh_ = vtr(vp_ + d0 * 4096 + ks * 1024 + 512); \
            const bf16x8 vf_ = (bf16x8){lo_[0], lo_[1], lo_[2], lo_[3], hh_[0], hh_[1], hh_[2], hh_[3]}; \
            o[d0] = __builtin_amdgcn_mfma_f32_32x32x16_bf16(__builtin_bit_cast(bf16x8, pw[ks]), vf_, o[d0], 0, 0, 0); } } while (0)
#define STEP9(C0, C1, N0, N1, t, ksl_next, DIAG, HASNEXT) do { if (!(DIAG) || ACT(t)) { \
        const bool nx_ = (HASNEXT) && (!(DIAG) || ACT((t) + 1)); bf16x8 kf_[NKS]; \
        if (!(DIAG) && nx_) { KFRAG(kf_, 0, ksl_next); } \
        DECIDE2(C0, C1, (t) == 0); SB(); \
        if ((DIAG) && nx_) { KFRAG(kf_, 0, ksl_next); } \
        if (nx_) { EXPSUMPACK(C0, C1); QKCHAIN(N0, kf_); SB(); KFRAG(kf_, 1, ksl_next); QKCHAIN(N1, kf_); SB(); \
            if (DIAG) MASK2(N0, N1, (t) + 1); } \
        else { EXPSUMPACK(C0, C1); SB(); } \
        PV8(VS(t)); SB(); } } while (0)
#define ROT() do { ks_cur = ks_n1; ks_n1 = ks_n2; ks_n2 = (ks_n2 == 2) ? 0 : ks_n2 + 1; } while (0)
#define VS(t) (((t) & 3) * 8192)
#define SYNC9(n) do { asm volatile("s_waitcnt vmcnt(" #n ") lgkmcnt(0)" ::: "memory"); __builtin_amdgcn_s_barrier(); asm volatile("" ::: "memory"); } while (0)
    int ks_cur = 0, ks_n1 = 1, ks_n2 = 2;
    QPIN();
    DMA_KA(0); DMA_KB(0); DMA_V(VS(0)); DMA_KA(1); DMA_KB(1); DMA_V(VS(1)); DMA_KA(2); DMA_KB(2);
    SYNC9(6);
    { bf16x8 kf_[NKS]; KFRAG(kf_, 0, 0); QKCHAIN(pA0, kf_); SB(); KFRAG(kf_, 1, 0); QKCHAIN(pA1, kf_); MASK2(pA0, pA1, 0); }
    SYNC9(3);
    ks_cur = 1; ks_n1 = 2; ks_n2 = 0;
    int t = 0;
    for (; t + 2 < NT - 4; t += 2) {
        DMA_KA(ks_n2); DMA_KB(ks_n2); DMA_V(VS(t + 2));
        STEP9(pA0, pA1, pB0, pB1, t, ks_cur, false, true); SYNC9(3); ROT();
        DMA_KA(ks_n2); DMA_KB(ks_n2); DMA_V(VS(t + 3));
        STEP9(pB0, pB1, pA0, pA1, t + 1, ks_cur, false, true); SYNC9(3); ROT();
    }
    for (; t < NT; t += 2) {
        const bool k3 = t + 3 < NT, v2 = t + 2 < NT;
        if (k3) { DMA_KA(ks_n2); DMA_KB(ks_n2); } if (v2) DMA_V(VS(t + 2));
        STEP9(pA0, pA1, pB0, pB1, t, ks_cur, true, true);
        if (k3) SYNC9(3); else SYNC9(0);
        ROT();
        const bool k3b = t + 4 < NT, v2b = t + 3 < NT;
        if (k3b) { DMA_KA(ks_n2); DMA_KB(ks_n2); } if (v2b) DMA_V(VS(t + 3));
        if (t + 2 < NT) STEP9(pB0, pB1, pA0, pA1, t + 1, ks_cur, true, true); else STEP9(pB0, pB1, pA0, pA1, t + 1, ks_cur, true, false);
        if (k3b) SYNC9(3); else SYNC9(0);
        ROT();
    }
#undef VS
#undef QPIN
#undef LOADT
#undef DMA_KA
#undef DMA_KB
#undef DMA_V
#undef GLDS16
#undef TILE_SYNC
#undef ACT
#undef SB
#undef SGB
#undef KFRAG
#undef QKCHAIN
#undef MASK2
#undef DECIDE2
#undef EXPSUMPACK
#undef PV8
#undef STEP9
#undef ROT
#undef SYNC9
    { auto rr = __builtin_amdgcn_permlane32_swap(__float_as_uint(l_run), __float_as_uint(l_run), false, false); l_run = __uint_as_float(rr[0]) + __uint_as_float(rr[1]); }
    if (hi == 0) wsf[32 + r32] = l_run; asm volatile("s_waitcnt lgkmcnt(0)" ::: "memory");
    float rli[16];
#pragma unroll
    for (int g = 0; g < 4; ++g) { const f32x4 a = *(const ALAS f32x4*)(wsf + 32 + 8 * g + 4 * hi);
#pragma unroll
        for (int i = 0; i < 4; ++i) rli[4 * g + i] = __builtin_amdgcn_rcpf(a[i]); }
    bf16_t* Ow = O + (tok0 + q0 + wid * 32) * OP + h * 64;
    { ALAS bf16_t* stg = (ALAS bf16_t*)(shm + L_OST) + wid * 2048;
#pragma unroll
      for (int r = 0; r < 16; ++r) { const int orow = crow(r, hi);
#pragma unroll
          for (int d0 = 0; d0 < 2; ++d0) stg[orow * 64 + d0 * 32 + r32] = (bf16_t)(cvtpk(o[d0][r] * rli[r], 0.f) & 0xffffu); }
      asm volatile("s_waitcnt lgkmcnt(0)" ::: "memory");
#pragma unroll
      for (int i = 0; i < 4; ++i) { const int row = i * 8 + (lane >> 3), ch = lane & 7; const u32x4 v = *(const ALAS u32x4*)(stg + row * 64 + ch * 8); *(u32x4*)(Ow + (long)row * OP + ch * 8) = v; } }
}
#undef ALAS
}
#define GAS __attribute__((address_space(1)))
#define LAS __attribute__((address_space(3)))
typedef unsigned short bf16;
typedef unsigned v4u __attribute__((ext_vector_type(4)));
typedef float f32x4 __attribute__((ext_vector_type(4)));
typedef short bf16x8 __attribute__((ext_vector_type(8)));
typedef GAS unsigned gu32;
typedef GAS unsigned long long gu64;
#define RLX_AGENT __ATOMIC_RELAXED, __HIP_MEMORY_SCOPE_AGENT
#define LDS_WAIT() asm volatile("s_waitcnt lgkmcnt(0)" ::: "memory")
#define VM_WAIT() asm volatile("s_waitcnt vmcnt(0)" ::: "memory")
__device__ __forceinline__ unsigned long long rt() { return __builtin_amdgcn_s_memrealtime(); }
__device__ __forceinline__ unsigned f2bf(float f) { unsigned u = __builtin_bit_cast(unsigned, f); return (u + 0x7fffu + ((u >> 16) & 1u)) >> 16; }
__device__ __forceinline__ unsigned pk2(float lo, float hi) { return f2bf(lo) | (f2bf(hi) << 16); }

#define XB_TMO      128
#define XB_XCNT(j)  (256  + 64 * (j))
#define XB_XSUB(j)  (1280 + 64 * (j))
#define XB_XGEN(j)  (2304 + 64 * (j))
#define XB_TOP      3328
#define XB_TOPGEN   3392
#define XCD_BAR_WORDS 3456
#define XB_SPIN_CAP (1u << 18)

__device__ __forceinline__ unsigned xb_ld(unsigned* p)              { return __hip_atomic_load(p, __ATOMIC_RELAXED, __HIP_MEMORY_SCOPE_AGENT); }
__device__ __forceinline__ unsigned xb_add(unsigned* p, unsigned v) { return __hip_atomic_fetch_add(p, v, __ATOMIC_RELAXED, __HIP_MEMORY_SCOPE_AGENT); }
__device__ __forceinline__ unsigned xb_xcc_id() { return (unsigned)__builtin_amdgcn_s_getreg((3 << 11) | 20) & 0xFu; }
#define XB_SPIN(cond, bar) do { unsigned _sp = 0; while (cond) { __builtin_amdgcn_s_sleep(1); \
    if ((++_sp & 255u) == 0u) { if (xb_ld(&(bar)[XB_TMO])) break; if (_sp > XB_SPIN_CAP) { atomicAdd(&(bar)[XB_TMO], 1u); break; } } } } while (0)

struct XcdBarrier {
    unsigned* bar; unsigned x;
    volatile LAS unsigned* st;
};

__device__ __forceinline__ XcdBarrier xcd_barrier_post(unsigned* bar, volatile LAS unsigned* st) {
    XcdBarrier b; b.bar = bar; b.x = xb_xcc_id(); b.st = st;
    if (threadIdx.x == 0) (void)xb_add(&bar[XB_XCNT(b.x)], 1u);
    return b;
}
__device__ __forceinline__ void xcd_barrier_complete(unsigned* bar, unsigned x, unsigned& nloc, unsigned& nx) {
    const unsigned G = gridDim.x * gridDim.y * gridDim.z;
    unsigned sum, cnt, mine, sp = 0u;
    for (;;) {
        sum = 0u; cnt = 0u; mine = 0u;
#pragma unroll
        for (unsigned j = 0; j < 16; ++j) { const unsigned c = xb_ld(&bar[XB_XCNT(j)]); sum += c; cnt += (c > 0u) ? 1u : 0u; mine = (j == x) ? c : mine; }
        if (sum == G) break;
        __builtin_amdgcn_s_sleep(1);
        if ((++sp & 255u) == 0u) { if (xb_ld(&bar[XB_TMO])) break; if (sp > XB_SPIN_CAP) { atomicAdd(&bar[XB_TMO], 1u); break; } }
    }
    nloc = mine > 0u ? mine : 1u; nx = cnt > 0u ? cnt : 1u;
}

__device__ __forceinline__ void xcd_barrier(const XcdBarrier& b) {
    asm volatile("s_waitcnt vmcnt(0)" ::: "memory");
    __syncthreads();
    if (threadIdx.x == 0) {
        unsigned* bar = b.bar;
        __builtin_amdgcn_s_waitcnt(0);
        unsigned nloc = b.st[0], nx = b.st[1];
        if (nloc == 0u) { xcd_barrier_complete(bar, b.x, nloc, nx); b.st[0] = nloc; b.st[1] = nx; }
        const unsigned old = xb_add(&bar[XB_XSUB(b.x)], 1u);
        const unsigned gen = old / nloc;
        if (old + 1u == (gen + 1u) * nloc) {
            __builtin_amdgcn_fence(__ATOMIC_RELEASE, "agent");
            asm volatile("s_waitcnt vmcnt(0)" ::: "memory");
            const unsigned og = xb_add(&bar[XB_TOP], 1u);
            const unsigned tg = og / nx;
            if (og + 1u == (tg + 1u) * nx) xb_add(&bar[XB_TOPGEN], 1u);
            else XB_SPIN(xb_ld(&bar[XB_TOPGEN]) == tg, bar);
            __builtin_amdgcn_fence(__ATOMIC_ACQUIRE, "agent");
            xb_add(&bar[XB_XGEN(b.x)], 1u);
            asm volatile("s_waitcnt vmcnt(0)" ::: "memory");
        } else {
            XB_SPIN(xb_ld(&bar[XB_XGEN(b.x)]) == gen, bar);
            __builtin_amdgcn_fence(__ATOMIC_ACQUIRE, "agent");
            asm volatile("s_waitcnt vmcnt(0)" ::: "memory");
        }
    }
    __syncthreads();
}
#ifndef MK_ABL
#define MK_ABL 0
#endif
#ifndef MK_REPEAT
#define MK_REPEAT (-1)
#endif
#ifndef MK_PRB_PHASE
#define MK_PRB_PHASE 1
#endif
#ifndef MK_STAMP_A
#define MK_STAMP_A 0
#define MK_STAMP_B 19
#endif
constexpr int NWAVES = 8;
constexpr int M_TOK = 16384, DMODEL = 1024, FHID = 2816, SEQLEN = 4096;
constexpr int N_PHASES = 10;
#ifndef MK_N_LAUNCHES
#define MK_N_LAUNCHES 1
#endif
constexpr int CW_BAR = 1024;
static_assert((CW_BAR + XCD_BAR_WORDS) * 4 <= (int)CTL_ZERO_BYTES, "barrier words inside the memset region");
constexpr int CW_GRP = 4608;
constexpr int CW_GOK = CW_GRP + 64 * 8;
constexpr int CW_CONV = CW_GOK + 64 * 8;
static_assert(CW_GRP >= CW_BAR + XCD_BAR_WORDS && (CW_CONV + 128) * 4 <= (int)CTL_ZERO_BYTES, "group words inside the memset region");
constexpr int RING_OFF = 0, RING_BYTES = 131072, LDSCTL_OFF = RING_BYTES, MISC_OFF = LDSCTL_OFF + 320, LDS_BYTES = 147456;

__device__ __constant__ float ROPE_INV_FREQ[16] = {1.0f, 0.5623413324356079f, 0.3162277638912201f, 0.17782793939113617f, 0.10000000149011612f, 0.05623413249850273f, 0.03162277489900589f, 0.017782794311642647f,
    0.009999999776482582f, 0.005623413249850273f, 0.003162277629598975f, 0.0017782794311642647f, 0.0010000000474974513f, 0.000562341301701963f, 0.0003162277571391314f, 0.00017782794020604342f};
__device__ __forceinline__ void sincos_acc(float af, float& s, float& c) {
    const double a = (double)af; const double k = rint(a * 0.6366197723675814);
    double r = fma(-k, 1.5707963267948966, a); r = fma(-k, 6.123233995736766e-17, r);
    const int q = ((int)k) & 3; const double r2 = r * r;
    double sp = -1.0 / 1307674368000.0; sp = fma(sp, r2, 1.0 / 6227020800.0); sp = fma(sp, r2, -1.0 / 39916800.0); sp = fma(sp, r2, 1.0 / 362880.0); sp = fma(sp, r2, -1.0 / 5040.0);
    sp = fma(sp, r2, 1.0 / 120.0); sp = fma(sp, r2, -1.0 / 6.0); sp = fma(sp, r2, 1.0); sp *= r;
    double cp = 1.0 / 20922789888000.0; cp = fma(cp, r2, -1.0 / 87178291200.0); cp = fma(cp, r2, 1.0 / 479001600.0); cp = fma(cp, r2, -1.0 / 3628800.0); cp = fma(cp, r2, 1.0 / 40320.0);
    cp = fma(cp, r2, -1.0 / 720.0); cp = fma(cp, r2, 1.0 / 24.0); cp = fma(cp, r2, -0.5); cp = fma(cp, r2, 1.0);
    const double ss = (q & 1) ? cp : sp, cc = (q & 1) ? sp : cp;
    s = (float)((q & 2) ? -ss : ss); c = (float)(((q + 1) & 2) ? -cc : cc);
}

struct Frame {
    LAS unsigned char* lds; volatile LAS unsigned* MISC; gu32* ctl;
    int tid, lane, wave, vcu, G;
    float* out; unsigned char* ws;
};
struct Args { const void* in[27]; float* out; unsigned char* ws; int ph_lo, ph_hi, li, pad; };
#define FIN(i) ((const float*)A.in[i])
__device__ __forceinline__ float wave_sum(float v) {
#pragma unroll
    for (int o = 1; o < 64; o <<= 1) v += __shfl_xor(v, o);
    return v;
}
__device__ __forceinline__ void st16_agent(bf16* p, v4u v) { asm volatile("global_store_dwordx4 %0, %1, off sc1" :: "v"(p), "v"(v) : "memory"); }
__device__ __forceinline__ void tr_item(const float* W, int ldn, int k0, int sc0, int ncol, bf16* dst, int Kp, int dr0, const float* gain, bool perm, LAS float* scr, int lane) {
    const int c32 = lane & 31;
    float wv[32], gv[32];
#pragma unroll
    for (int i = 0; i < 32; ++i) { const int kk = 2 * i + (lane >> 5); wv[i] = (c32 < ncol) ? W[(size_t)(k0 + kk) * ldn + sc0 + c32] : 0.f; gv[i] = gain ? gain[k0 + kk] : 1.0f; }
#pragma unroll
    for (int i = 0; i < 32; ++i) { const int kk = 2 * i + (lane >> 5); scr[kk * 33 + c32] = wv[i] * gv[i]; }
    LDS_WAIT(); asm volatile("" ::: "memory");
    const int c = lane & 7;
#pragma unroll
    for (int j = 0; j < 4; ++j) { const int n = (lane >> 3) + 8 * j; const LAS float* s = scr + (8 * c) * 33 + n;
        const int dn = perm ? (8 * ((n >> 2) & 3) + 4 * (n >> 4) + (n & 3)) : n;
        v4u o; o.x = pk2(s[0 * 33], s[1 * 33]); o.y = pk2(s[2 * 33], s[3 * 33]); o.z = pk2(s[4 * 33], s[5 * 33]); o.w = pk2(s[6 * 33], s[7 * 33]);
        st16_agent(dst + (size_t)(dr0 + dn) * Kp + k0 + 8 * c, o); }
    LDS_WAIT(); asm volatile("" ::: "memory");
}
__device__ __forceinline__ void zero_item(bf16* dst, int Kp, int dr0, int k0, int lane) {
    const int c = lane & 7;
#pragma unroll
    for (int j = 0; j < 4; ++j) { const int n = (lane >> 3) + 8 * j; st16_agent(dst + (size_t)(dr0 + n) * Kp + k0 + 8 * c, (v4u){0u, 0u, 0u, 0u}); }
}
constexpr int WD2_LO = (2 * 16 * 88 + 44 * 32) + 2 * 16 * 88, WD2_HI = 2 * (2 * 16 * 88 + 44 * 32);
constexpr int P0_ITEMS_NOW = 2 * 16 * 88, P0_NITEMS = 2 * (2 * 16 * 88 + 44 * 32) + 124 * 16 + 24 * 3 + 32 * 2 + 2 * 32 * 8 + 32 * 16 + 4 * 16 + 24;
__device__ __forceinline__ void p0_items(Frame& F, const Args& A, int lo, int hi, int gw, int NGW) {
    LAS float* scr = (LAS float*)(F.lds + RING_OFF + F.wave * 16384);
    const int lane = F.lane;
    unsigned char* ws = F.ws;
    constexpr int I_GU = 16 * 88, I_D = 44 * 32, I_FFN = 2 * I_GU + I_D, I_WIN = 124 * 16, I_QB = 24 * 3, I_KVB = 32 * 2, I_AB = 32 * 8, I_O = 32 * 16, I_ZW = 4 * 16, I_ZQ = 24;
    constexpr int NITEMS = 2 * I_FFN + I_WIN + I_QB + I_KVB + 2 * I_AB + I_O + I_ZW + I_ZQ;
    static_assert(NITEMS == P0_NITEMS, "item count");
    for (int it0 = lo + gw; it0 < hi; it0 += NGW) {
        int r = it0;
        if (r < 2 * I_FFN) { const int layer = r / I_FFN; r -= layer * I_FFN; const int mat = r / I_GU; r -= mat * I_GU;
            const float* gainp = layer ? FIN(23) : FIN(2);
            if (mat < 2) { const int kb = r / 88, nb = r % 88; const float* w = mat ? (layer ? FIN(25) : FIN(4)) : (layer ? FIN(24) : FIN(3));
                tr_item(w, FHID, 64 * kb, 32 * nb, 32, (bf16*)(ws + (layer ? WS_WGU2 : WS_WGU1)), 1024, 256 * (nb >> 2) + 32 * (nb & 3) + 128 * mat, gainp, false, scr, lane); }
            else { const int kb = r / 32, nb = r % 32; tr_item(layer ? FIN(26) : FIN(5), DMODEL, 64 * kb, 32 * nb, 32, (bf16*)(ws + (layer ? WS_WD2 : WS_WD1)), FHID, 32 * nb, nullptr, false, scr, lane); }
            continue; }
        r -= 2 * I_FFN;
        if (r < I_WIN) { const int kb = r / 124, nb = r % 124; int sc0, dr0, ncol = 32; bool perm = false;
            if (nb < 6) { sc0 = 32 * nb; dr0 = 32 * nb; }
            else if (nb < 10) { sc0 = 192 + 32 * (nb - 6); dr0 = 256 + 32 * (nb - 6); }
            else if (nb == 10) { sc0 = 320; dr0 = 384; perm = true; }
            else if (nb == 11) { sc0 = 1888; dr0 = 416; ncol = 8; }
            else if (nb < 60) { const int j = nb - 12, kind = j >> 4, jj = j & 15, h = jj >> 1, bj = jj & 1; sc0 = 352 + 512 * kind + 64 * h + 32 * bj; dr0 = 512 + 512 * kind + 256 * (h >> 2) + 128 * bj + 32 * (h & 3); }
            else { const int j = nb - 60; sc0 = 1896 + 32 * j; dr0 = 2048 + 32 * j; }
            tr_item(FIN(7), 3944, 64 * kb, sc0, ncol, (bf16*)(ws + WS_WIN), 1024, dr0, FIN(6), perm, scr, lane); continue; }
        r -= I_WIN;
        if (r < I_QB) { const int kb = r / 24, nb = r % 24; int sc0, dr0; bool perm = false;
            if (nb < 16) { const int h = nb >> 1, bj = nb & 1; sc0 = 96 * h + 32 * bj; dr0 = 256 * (h >> 2) + 128 * bj + 32 * (h & 3); }
            else { const int h = nb - 16; sc0 = 96 * h + 64; dr0 = 512 + 128 * (h >> 2) + 32 * (h & 3); perm = true; }
            tr_item(FIN(9), 768, 64 * kb, sc0, 32, (bf16*)(ws + WS_WQB), 256, dr0, FIN(8), perm, scr, lane); continue; }
        r -= I_QB;
        if (r < I_KVB) { const int kb = r / 32, nb = r % 32; const int j = nb & 15, h = j >> 1, bj = j & 1, isv = nb >> 4;
            tr_item(FIN(11), 1024, 64 * kb, 128 * h + 64 * isv + 32 * bj, 32, (bf16*)(ws + WS_WKVB), 128, 512 * isv + 256 * (h >> 2) + 128 * bj + 32 * (h & 3), FIN(10), false, scr, lane); continue; }
        r -= I_KVB;
        if (r < 2 * I_AB) { const int which = r / I_AB; r -= which * I_AB; const int kb = r / 32, nb = r % 32;
            tr_item(which ? FIN(20) : FIN(19), DMODEL, 64 * kb, 32 * nb, 32, (bf16*)(ws + WS_WAB), 512, 1024 * which + 32 * nb, nullptr, false, scr, lane); continue; }
        r -= 2 * I_AB;
        if (r < I_O) { const int kb = r / 32, nb = r % 32; tr_item(FIN(22), DMODEL, 64 * kb, 32 * nb, 32, (bf16*)(ws + WS_WO), 1024, 32 * nb, nullptr, false, scr, lane); continue; }
        r -= I_O;
        if (r < I_ZW) { const int kb = r >> 2, rb = r & 3; zero_item((bf16*)(ws + WS_WIN), 1024, (rb < 2 ? 192 + 32 * rb : 448 + 32 * (rb - 2)), 64 * kb, lane); continue; }
        r -= I_ZW;
        zero_item((bf16*)(ws + WS_WQB), 256, 32 * r, 192, lane);
    }
}
__device__ __forceinline__ void p0_prologue(Frame& F, const Args& A) {
    const int gw = F.vcu * NWAVES + F.wave, NGW = F.G * NWAVES, lane = F.lane;
    unsigned char* ws = F.ws;
    p0_items(F, A, 0, (F.G == 256) ? P0_ITEMS_NOW : P0_NITEMS, gw, NGW);
    { const float* x = FIN(0); bf16* xb = (bf16*)(ws + WS_XB); float* ss0 = (float*)(ws + WS_SS0);
      for (int m0 = gw; m0 < M_TOK * ((MK_REPEAT == 0 || MK_REPEAT == 11) ? 2 : 1); m0 += NGW) { const int m = m0 % M_TOK; const GAS f32x4* xr = (const GAS f32x4*)(x + (size_t)m * DMODEL) + lane; f32x4 v[4]; float s = 0.f;
#pragma unroll
          for (int j = 0; j < 4; ++j) { v[j] = xr[64 * j]; s += (v[j].x * v[j].x + v[j].y * v[j].y) + (v[j].z * v[j].z + v[j].w * v[j].w); }
          s = wave_sum(s);
          GAS unsigned long long* o8 = (GAS unsigned long long*)(xb + (size_t)m * DMODEL) + lane;
#pragma unroll
          for (int j = 0; j < 4; ++j) o8[64 * j] = (unsigned long long)pk2(v[j].x, v[j].y) | ((unsigned long long)pk2(v[j].z, v[j].w) << 32);
          if (lane == 0) *(GAS f32x4*)(ss0 + 4 * (size_t)m) = (f32x4){s, 0.f, 0.f, 0.f}; } }
    { float* par = (float*)(ws + WS_PAR);
      for (int i = (F.vcu * NWAVES + F.wave) * 64 + lane; i < PAR_N; i += F.G * NWAVES * 64) { float v = 0.f;
          if (i < 64) v = FIN(16)[i]; else if (i < 128) v = FIN(17)[i - 64]; else if (i < 160) v = FIN(15)[i - 128]; else if (i < 168) v = FIN(18)[i - 160];
          else if (i >= 192 && i < 256) v = FIN(12)[i - 192]; else if (i >= 256 && i < 288) v = FIN(13)[i - 256]; else if (i >= 320 && i < 384) v = FIN(14)[i - 320]; else if (i >= 1024) v = FIN(21)[i - 1024];
          par[i] = v; } }
    { const int* pos = (const int*)A.in[1]; float* cosT = (float*)(ws + WS_COS); float* sinT = (float*)(ws + WS_SIN);
      for (int idx = (F.vcu * NWAVES + F.wave) * 64 + lane; idx < M_TOK * 16; idx += F.G * NWAVES * 64) { float sn, cs; sincos_acc((float)pos[idx >> 4] * ROPE_INV_FREQ[idx & 15], sn, cs); cosT[idx] = cs; sinT[idx] = sn; } }
}
__device__ __forceinline__ void cum_phase(Frame& F) {
    for (int bh = F.vcu; bh < 32; bh += F.G) { const int b = bh >> 3, h = bh & 7; const float* lf = (const float*)(F.ws + WS_LOGF) + ((size_t)b * SEQLEN) * 8 + h;
        LAS float* wsum = (LAS float*)(F.lds + RING_OFF);
        float v[8], run = 0.f;
#pragma unroll
        for (int i = 0; i < 8; ++i) { run += lf[(size_t)(8 * F.tid + i) * 8]; v[i] = run; }
        float inc = run;
#pragma unroll
        for (int o = 1; o < 64; o <<= 1) { const float t = __shfl_up(inc, o); if (F.lane >= o) inc += t; }
        if (F.lane == 63) wsum[F.wave] = inc;
        __syncthreads();
        float base = inc - run;
        for (int w = 0; w < F.wave; ++w) base += wsum[w];
#pragma unroll
        for (int i = 0; i < 8; ++i) { const float val = -1.4426950408889634f * (v[i] + base);
            const unsigned hi_ = f2bf(val); const float r1 = val - __uint_as_float(hi_ << 16); const unsigned mid_ = f2bf(r1); const float r2 = r1 - __uint_as_float(mid_ << 16); const unsigned lo_ = f2bf(r2);
            GAS v4u* dst = (GAS v4u*)((bf16*)(F.ws + WS_KAUG) + (((size_t)b * SEQLEN + 8 * F.tid + i) * 8 + h) * 16);
            dst[0] = (v4u){hi_ | (mid_ << 16), lo_, 0u, 0u}; dst[1] = (v4u){0u, 0u, 0u, 0u}; }
        __syncthreads(); }
}

__device__ __forceinline__ void grp_barrier(const Frame& F, int conv, unsigned need) {
    asm volatile("s_waitcnt vmcnt(0)" ::: "memory");
    __syncthreads();
    if (threadIdx.x == 0) {
        unsigned* bar = (unsigned*)(F.ctl + CW_BAR);
        __builtin_amdgcn_s_waitcnt(0);
        const unsigned g = blockIdx.x & 7u, size = (unsigned)F.G >> 3;
        unsigned* cnt = (unsigned*)(F.ctl + CW_GRP + 64 * g);
        if (F.MISC[12] == 0u) { __builtin_amdgcn_fence(__ATOMIC_RELEASE, "agent"); asm volatile("s_waitcnt vmcnt(0)" ::: "memory"); }
        const unsigned old = xb_add(cnt, 1u), target = (old / size + 1u) * size;
        XB_SPIN(xb_ld(cnt) < target, bar);
        if (conv >= 0) { unsigned* cw = (unsigned*)(F.ctl + conv); XB_SPIN(xb_ld(cw) < need, bar); }
        __builtin_amdgcn_fence(__ATOMIC_ACQUIRE, "agent");
        asm volatile("s_waitcnt vmcnt(0)" ::: "memory");
    }
    __syncthreads();
}
__device__ __forceinline__ void conv_done(const Frame& F, int conv) {
    asm volatile("s_waitcnt vmcnt(0)" ::: "memory");
    __syncthreads();
    if (threadIdx.x == 0) (void)xb_add((unsigned*)(F.ctl + conv), 1u);
}

__global__ void __launch_bounds__(NWAVES * 64, 2) mega_fwd(Args A) {
    extern __shared__ __attribute__((aligned(16))) unsigned char lds[];
    Frame F;
    F.lds = (LAS unsigned char*)lds; F.MISC = (volatile LAS unsigned*)(F.lds + MISC_OFF);
    F.tid = threadIdx.x; F.lane = F.tid & 63; F.wave = __builtin_amdgcn_readfirstlane(F.tid >> 6);
    F.G = gridDim.x; { const int bx = blockIdx.x; F.vcu = (F.G % 8 == 0) ? (bx % 8) * (F.G / 8) + bx / 8 : bx; }
    F.out = A.out; F.ws = A.ws; F.ctl = (gu32*)(A.ws + WS_CTL);
    unsigned char* ws = A.ws;
    for (int u = F.tid; u < (LDS_BYTES - LDSCTL_OFF) / 4; u += NWAVES * 64) ((LAS unsigned*)(F.lds + LDSCTL_OFF))[u] = 0u;
    __syncthreads();
    XcdBarrier bar; bar.bar = (unsigned*)(F.ctl + CW_BAR); bar.x = 0; bar.st = nullptr;
    if (MK_N_LAUNCHES == 1) bar = xcd_barrier_post((unsigned*)(F.ctl + CW_BAR), F.MISC + 8);
    const bool gseam = (MK_N_LAUNCHES == 1) && F.G == 256;
    if (gseam && F.tid == 0 && xb_xcc_id() == (blockIdx.x & 7u)) (void)xb_add((unsigned*)(F.ctl + CW_GOK + 64 * (blockIdx.x & 7)), 1u);
    const int lo = A.ph_lo, hi = A.ph_hi;
#define REP(k) for (int rep_ = 0; rep_ < (((k) == MK_REPEAT && (k) != 0) ? 2 : 1); ++rep_)
#if defined(MK_PRB)
#define STAMP(i) do { if (blockIdx.x == 0 && F.tid == 0) { F.MISC[16 + (i)] = (unsigned)rt(); g_prb_on = ((i) == 2 * MK_PRB_PHASE) ? 1 : 0; } } while (0)
#else
#define STAMP(i) do { } while (0)
#endif
#define IN(k) (lo <= (k) && (k) < hi)
#define SEAM_G(k, conv, need) do { STAMP(2 * (k) + 1); if (IN(k) && IN((k) + 1)) { if (gseam) grp_barrier(F, conv, need); else xcd_barrier(bar); } STAMP(2 * (k) + 2); } while (0)
#define SEAM(k) do { STAMP(2 * (k) + 1); if (IN(k) && IN((k) + 1)) { xcd_barrier(bar); if (MK_REPEAT == 20) xcd_barrier(bar); } STAMP(2 * (k) + 2); } while (0)
    using pg8::Gemm; using pg8::StaticOrder;
    bf16* XB = (bf16*)(ws + WS_XB); bf16* HB = (bf16*)(ws + WS_H);
    float* SS0 = (float*)(ws + WS_SS0); float* SS1 = (float*)(ws + WS_SS1); float* SS2 = (float*)(ws + WS_SS2);

    STAMP(0);
#if defined(MK_PRB)
    if (blockIdx.x == 0 && F.tid == 0) { for (int i = 0; i < 8; ++i) g_prb[i] = 0; g_prb_on = 0; }
#endif
    if (IN(0)) { REP(0) p0_prologue(F, A); } SEAM(0);
    if (gseam && F.tid == 0) F.MISC[12] = (xb_ld((unsigned*)(F.ctl + CW_GOK + 64 * (blockIdx.x & 7))) == (unsigned)F.G / 8u) ? 1u : 0u;
    if (IN(1)) REP(1) { Gemm g{XB, (const bf16*)(ws + WS_WGU1), M_TOK, 2 * FHID, DMODEL}; StaticOrder S; S.init(M_TOK, 2 * FHID, F.G, (int)blockIdx.x);
        pg8::EpiSwiglu E{HB, SS0, FHID}; pg8::gemm_phase<pg8::EpiSwiglu, StaticOrder, true, true>(F.lds + RING_OFF, g, S, E);
        if (F.G == 256 && blockIdx.x >= 128) { p0_items(F, A, P0_ITEMS_NOW, WD2_LO, ((int)blockIdx.x - 128) * NWAVES + F.wave, 128 * NWAVES); p0_items(F, A, WD2_HI, P0_NITEMS, ((int)blockIdx.x - 128) * NWAVES + F.wave, 128 * NWAVES); if (gseam) conv_done(F, CW_CONV); } } SEAM_G(1, CW_CONV, 128u);
    if (IN(2)) REP(2) { Gemm g{HB, (const bf16*)(ws + WS_WD1), M_TOK, DMODEL, FHID}; StaticOrder S; S.init(M_TOK, DMODEL, F.G, (int)blockIdx.x);
        pg8::EpiResid<true, true, true> E{XB, nullptr, XB, SS1}; pg8::gemm_phase<pg8::EpiResid<true, true, true>, StaticOrder, false, true>(F.lds + RING_OFF, g, S, E); } SEAM(2);
    if (IN(3)) REP(3) { Gemm g{XB, (const bf16*)(ws + WS_WIN), M_TOK, 4096, DMODEL}; StaticOrder S; S.init(M_TOK, 4096, F.G, (int)blockIdx.x);
        pg8::EpiWin E{ws};
        pg8::gemm_phase<pg8::EpiWin, StaticOrder, true, true>(F.lds + RING_OFF, g, S, E); } SEAM(3);
    if (IN(4)) REP(4) { cum_phase(F);
        { int kq = 256; asm volatile("" : "+s"(kq)); Gemm g{(const bf16*)(ws + WS_QLAT), (const bf16*)(ws + WS_WQB), M_TOK, 768, kq}; StaticOrder S; S.init(M_TOK, 768, F.G, (int)blockIdx.x);
          pg8::EpiMlaQ E{ws}; pg8::gemm_phase<pg8::EpiMlaQ, StaticOrder, true, true>(F.lds + RING_OFF, g, S, E); }
        { int kq = 128; asm volatile("" : "+s"(kq)); Gemm g{(const bf16*)(ws + WS_KVLAT), (const bf16*)(ws + WS_WKVB), M_TOK, 1024, kq}; StaticOrder S; S.init(M_TOK, 1024, F.G, (int)blockIdx.x);
          pg8::EpiMlaKV E{ws, (bf16*)F.out}; pg8::gemm_phase<pg8::EpiMlaKV, StaticOrder, true, true>(F.lds + RING_OFF, g, S, E); } } SEAM(4);
    if (IN(5)) REP(5) { bf16* omla = (bf16*)(ws + WS_YCAT); bf16* ofox = (bf16*)(ws + WS_QF);
#if MK_REPEAT == 5
        if (rep_ == 0) { bf16* dmy = (bf16*)F.out + 16 * MiB / 2;
            for (int v = F.vcu; v < 256; v += F.G) { const int bh = v >> 3, s = v & 7, b = bh >> 3, h = bh & 7;
                for (int i = 0; i < 2; ++i) att::attn_unit<6, false, 768, 96, 512, 32, 0, 512, 512, MK_ABL>(b, h, i ? 15 - s : s, (const bf16*)(ws + WS_QM), (const bf16*)(ws + WS_KM), (const bf16*)(ws + WS_KR), (const bf16*)F.out, dmy, (LAS char*)F.lds);
                for (int i = 0; i < 2; ++i) att::attn_unit<5, true, 512, 64, 512, 128, 16, 512, 512, MK_ABL>(b, h, i ? 15 - s : s, (const bf16*)(ws + WS_QF), (const bf16*)(ws + WS_KF), (const bf16*)(ws + WS_KAUG), (const bf16*)(ws + WS_VF), dmy, (LAS char*)F.lds); }
            continue; }
#endif
        if (F.wave >= 4) __builtin_amdgcn_s_setprio(1);
        for (int v = F.vcu; v < 256; v += F.G) { const int bh = v >> 3, s = v & 7, b = bh >> 3, h = bh & 7;
            for (int i = 0; i < 2; ++i) att::attn_unit<6, false, 768, 96, 512, 32, 0, 512, 512>(b, h, i ? 15 - s : s, (const bf16*)(ws + WS_QM), (const bf16*)(ws + WS_KM), (const bf16*)(ws + WS_KR), (const bf16*)F.out, omla, (LAS char*)F.lds);
            for (int i = 0; i < 2; ++i) att::attn_unit9<5, true, 512, 64, 512, 128, 16, 512, 512>(b, h, i ? 15 - s : s, (const bf16*)(ws + WS_QF), (const bf16*)(ws + WS_KF), (const bf16*)(ws + WS_KAUG), (const bf16*)(ws + WS_VF), ofox, (LAS char*)F.lds); }
        __builtin_amdgcn_s_setprio(0); } SEAM(5);
    if (IN(6)) REP(6) { Gemm g{(const bf16*)(ws + WS_YCAT), (const bf16*)(ws + WS_WAB), 2 * M_TOK, 2048, 512}; pg8::BranchOrder S; S.init(F.G, (int)blockIdx.x);
        pg8::EpiBranch E{ws}; pg8::gemm_phase<pg8::EpiBranch, pg8::BranchOrder, true, true>(F.lds + RING_OFF, g, S, E); } SEAM_G(6, -1, 0u);
    if (IN(7)) { Gemm g{(const bf16*)(ws + WS_MIXED), (const bf16*)(ws + WS_WO), M_TOK, DMODEL, DMODEL}; StaticOrder S; S.init(M_TOK, DMODEL, F.G, (int)blockIdx.x);
        pg8::EpiResid<false, true, true> E{XB, nullptr, (bf16*)(ws + WS_X2B), SS2}; pg8::gemm_phase<pg8::EpiResid<false, true, true>, StaticOrder, false, true>(F.lds + RING_OFF, g, S, E); } SEAM(7);
    if (IN(8)) REP(8) { Gemm g{(const bf16*)(ws + WS_X2B), (const bf16*)(ws + WS_WGU2), M_TOK, 2 * FHID, DMODEL}; StaticOrder S; S.init(M_TOK, 2 * FHID, F.G, (int)blockIdx.x);
        pg8::EpiSwiglu E{HB, SS2, FHID}; pg8::gemm_phase<pg8::EpiSwiglu, StaticOrder, true, true>(F.lds + RING_OFF, g, S, E);
        if (F.G == 256 && blockIdx.x >= 128) { p0_items(F, A, WD2_LO, WD2_HI, ((int)blockIdx.x - 128) * NWAVES + F.wave, 128 * NWAVES); if (gseam) conv_done(F, CW_CONV + 64); } } SEAM_G(8, CW_CONV + 64, 128u);
    if (IN(9)) { Gemm g{HB, (const bf16*)(ws + WS_WD2), M_TOK, DMODEL, FHID}; StaticOrder S; S.init(M_TOK, DMODEL, F.G, (int)blockIdx.x);
        pg8::EpiResid<true, true, false> E{(const bf16*)(ws + WS_X2B), F.out, nullptr, nullptr}; pg8::gemm_phase<pg8::EpiResid<true, true, false>, StaticOrder, false, true>(F.lds + RING_OFF, g, S, E); }
    STAMP(19);
#if defined(MK_PRB)
    if (blockIdx.x == 0 && F.tid == 0) { unsigned long long v = g_prb[MK_PRB & 7]; if (MK_PRB == 6) v = (unsigned long long)(F.MISC[16 + MK_STAMP_B] - F.MISC[16 + MK_STAMP_A]);
        const unsigned long long wait = 4ull * v, t0 = rt(); while (rt() - t0 < wait) __builtin_amdgcn_s_sleep(8); }
#endif
#undef IN
#undef SEAM
#undef SEAM_G
}

static int mega_setup() {
    static int grid = 0;
    if (grid == 0) {
        int dev = 0, cus = 0;
        if (hipGetDevice(&dev) != hipSuccess || hipDeviceGetAttribute(&cus, hipDeviceAttributeMultiprocessorCount, dev) != hipSuccess) { fprintf(stderr, "mega: device query failed\n"); grid = -1; return grid; }
        if (hipFuncSetAttribute((const void*)mega_fwd, hipFuncAttributeMaxDynamicSharedMemorySize, LDS_BYTES) != hipSuccess) { fprintf(stderr, "mega: hipFuncSetAttribute failed\n"); grid = -1; return grid; }
        int per_cu = 0;
        if (hipOccupancyMaxActiveBlocksPerMultiprocessor(&per_cu, (const void*)mega_fwd, NWAVES * 64, LDS_BYTES) != hipSuccess || per_cu < 1)
            fprintf(stderr, "mega: the occupancy query reports %d workgroups per CU (need 1): check the build's VGPR / LDS numbers\n", per_cu);
        (void)hipGetLastError();
        grid = cus;
        if (grid != 256) fprintf(stderr, "mega: %d CUs; the one-unit-per-workgroup phases assume 256\n", grid);
    }
    return grid;
}
static void mega_launch(void* const* d_in, float* d_out, unsigned char* ws, hipStream_t stream, int ph_lo, int ph_hi) {
    const int grid = mega_setup(); if (grid <= 0) return;
    Args a{};
    for (int i = 0; i < 27; ++i) a.in[i] = d_in[i];
    a.out = d_out; a.ws = ws; a.ph_lo = ph_lo; a.ph_hi = ph_hi; a.li = 0; a.pad = 0;
    hipLaunchKernelGGL(mega_fwd, dim3(grid), dim3(NWAVES * 64), LDS_BYTES, stream, a);
}
extern "C" void kernel_launch(void* const* d_in, const int* in_sizes, int n_in, void* d_out, int out_size, void* d_ws, size_t ws_size, hipStream_t stream) {
    if (n_in != 27 || in_sizes[0] != M_TOK * DMODEL || out_size != M_TOK * DMODEL || ws_size < WS_END) { fprintf(stderr, "kernel_launch: unexpected problem shape; nothing launched\n"); return; }
    unsigned char* ws = (unsigned char*)d_ws;
    (void)hipMemsetAsync(ws + WS_CTL, 0, CTL_ZERO_BYTES, stream);
    if (MK_N_LAUNCHES == 1) mega_launch(d_in, (float*)d_out, ws, stream, 0, N_PHASES);
    else for (int p = 0; p < N_PHASES; ++p) mega_launch(d_in, (float*)d_out, ws, stream, p, p + 1);
}
```

```cpp
#include <hip/hip_runtime.h>
#include <cstdint>
#include <cstdio>
constexpr size_t MiB = 1u << 20, KiB = 1u << 10;
constexpr size_t WS_CTL = 0, CTL_ZERO_BYTES = 64 * KiB;
constexpr size_t WS_SS0 = 1 * MiB, WS_SS1 = WS_SS0 + 256 * KiB, WS_SS2 = WS_SS1 + 256 * KiB, WS_SSQ = WS_SS2 + 256 * KiB, WS_SSKV = 2 * MiB, WS_LOGF = WS_SSKV + 256 * KiB;
constexpr size_t WS_PAR = 2 * MiB + 768 * KiB;
constexpr int PAR_FQG = 0, PAR_FKG = 64, PAR_KRG = 128, PAR_BF = 160, PAR_QNG = 192, PAR_QRG = 256, PAR_KNG = 320, PAR_BG = 1024, PAR_N = 3072;
constexpr size_t WS_CUM = 3 * MiB, WS_COS = 4 * MiB, WS_SIN = 5 * MiB, WS_KR = 6 * MiB;
constexpr size_t WS_WGU1 = 8 * MiB, WS_WD1 = 19 * MiB, WS_QLAT = 8 * MiB, WS_KVLAT = 16 * MiB, WS_KAUG = 20 * MiB;
constexpr size_t WS_WGU2 = 25 * MiB, WS_WD2 = 36 * MiB, WS_WIN = 42 * MiB, WS_WAB = 50 * MiB, WS_WO = 52 * MiB, WS_WQB = 54 * MiB, WS_WKVB = 54 * MiB + 512 * KiB;
constexpr size_t WS_XB = 56 * MiB, WS_VM = 72 * MiB;
constexpr size_t WS_H = 88 * MiB, WS_QM = 88 * MiB, WS_T1 = 88 * MiB, WS_MIXED = 88 * MiB  , WS_KM = 112 * MiB, WS_YCAT = 128 * MiB, WS_QF = 144 * MiB, WS_VF = 160 * MiB;
constexpr size_t WS_GATES = 176 * MiB, WS_X2B = 176 * MiB, WS_KF = 240 * MiB, WS_END = 256 * MiB;
#if defined(MK_PRB)
__device__ unsigned long long g_prb[8]; __device__ int g_prb_on;
#define PRB_T0() unsigned long long prb_t_ = __builtin_amdgcn_s_memrealtime()
#define PRB_RE() do { prb_t_ = __builtin_amdgcn_s_memrealtime(); } while (0)
#define PRB_ACC(i) do { const unsigned long long n_ = __builtin_amdgcn_s_memrealtime(); if (blockIdx.x == 0 && threadIdx.x == 0) g_prb[i] += n_ - prb_t_; prb_t_ = n_; } while (0)
#define PRB_ACC_IF(i) do { const unsigned long long n_ = __builtin_amdgcn_s_memrealtime(); if (blockIdx.x == 0 && threadIdx.x == 0 && g_prb_on) g_prb[i] += n_ - prb_t_; prb_t_ = n_; } while (0)
#else
#define PRB_T0() do { } while (0)
#define PRB_RE() do { } while (0)
#define PRB_ACC(i) do { } while (0)
#define PRB_ACC_IF(i) do { } while (0)
#endif
namespace pg8 {
#define PG8_LAS __attribute__((address_space(3)))
typedef unsigned short bf16_t;
typedef short bf16x8 __attribute__((ext_vector_type(8)));
typedef float f32x4 __attribute__((ext_vector_type(4)));
typedef unsigned u32x4 __attribute__((ext_vector_type(4)));
constexpr int BM = 256, BK = 64, HALF = 128, HTB = HALF * BK * 2  , STAGE_BYTES = 8 * HTB, NXCD = 8, WGM = 8;

__host__ __device__ __forceinline__ int lds_byte(int r, int c) { const int st = (r >> 4) * 2 + (c >> 5), rr = r & 15, cc = c & 31, ob = rr * 64 + cc * 2; return st * 1024 + (ob ^ (((ob >> 9) & 1) << 5)); }
__host__ __device__ __forceinline__ void stage_rc(int b, int& R, int& C) { const int st = b / 1024, sb = b % 1024, swz = sb ^ (((sb >> 9) & 1) << 5); R = (st >> 1) * 16 + swz / 64; C = (st & 1) * 32 + (swz % 64) / 2; }
__host__ __device__ __forceinline__ int perm32(int rho) { const int n = rho >> 4, i = rho & 15; return 8 * (i >> 2) + 4 * n + (i & 3); }

struct Unit { int pm, pn; };
struct Gemm { const bf16_t* A; const bf16_t* Bt; int M, N, K; };

struct StaticOrder {
    int nM, nN, nwg, G, c;
    __host__ __device__ void init(int M, int N, int G_, int c_) { nM = M / BM; nN = N / BM; nwg = nM * nN; G = G_; c = c_; }
    __host__ __device__ bool next(int i, Unit& u) const {
        const long L = (long)i * G + c; if (L >= nwg) return false;
        int wgid = (int)L; { const int q = nwg / NXCD, r = nwg % NXCD, xcd = wgid % NXCD, off = wgid / NXCD; wgid = (xcd < r ? xcd * (q + 1) : r * (q + 1) + (xcd - r) * q) + off; }
        const int nig = WGM * nN, gid = wgid / nig, fm = gid * WGM, gsz = (nM - fm) < WGM ? (nM - fm) : WGM;
        u.pm = fm + ((wgid % nig) % gsz); u.pn = (wgid % nig) / gsz; return true;
    }
    __device__ __forceinline__ void a_ready(const Unit&) const {}
    __device__ __forceinline__ void done(const Unit&) const {}
};

typedef float f32x2_cv __attribute__((ext_vector_type(2))); typedef __bf16 bf16x2_cv __attribute__((ext_vector_type(2)));
__device__ __forceinline__ unsigned cvt_pk_bf16(float lo, float hi) { f32x2_cv v = {lo, hi}; bf16x2_cv b = __builtin_convertvector(v, bf16x2_cv); return __builtin_bit_cast(unsigned, b); }
typedef float f32x2 __attribute__((ext_vector_type(2)));
constexpr float RMS_EPS = 1e-6f;
constexpr float LOG2E = 1.4426950408889634f;
constexpr float C2F = 0.125f * 1.4426950408889634f;
constexpr float C2M = 0.10206207261596575f * 1.4426950408889634f;
__device__ __forceinline__ u32x4 pack8(f32x4 a, f32x4 b) { u32x4 w; w.x = cvt_pk_bf16(a[0], a[1]); w.y = cvt_pk_bf16(a[2], a[3]); w.z = cvt_pk_bf16(b[0], b[1]); w.w = cvt_pk_bf16(b[2], b[3]); return w; }
__device__ __forceinline__ void unpack8(u32x4 w, f32x4& a, f32x4& b) {
    a[0] = __uint_as_float(w.x << 16); a[1] = __uint_as_float(w.x & 0xffff0000u); a[2] = __uint_as_float(w.y << 16); a[3] = __uint_as_float(w.y & 0xffff0000u);
    b[0] = __uint_as_float(w.z << 16); b[1] = __uint_as_float(w.z & 0xffff0000u); b[2] = __uint_as_float(w.w << 16); b[3] = __uint_as_float(w.w & 0xffff0000u); }
__device__ __forceinline__ float rstd4(const float* ss, int row, float invn) { const f32x4 s = *(const f32x4*)(ss + 4 * (size_t)row); return __builtin_amdgcn_rsqf(((s[0] + s[1]) + (s[2] + s[3])) * invn + RMS_EPS); }
__device__ __forceinline__ float dot4(f32x4 a) { return (a[0] * a[0] + a[1] * a[1]) + (a[2] * a[2] + a[3] * a[3]); }
__device__ __forceinline__ float sig1(float z) { return __builtin_amdgcn_rcpf(1.0f + __builtin_amdgcn_exp2f(-LOG2E * z)); }
__device__ __forceinline__ f32x4 sig4(f32x4 z) { f32x4 r; r[0] = sig1(z[0]); r[1] = sig1(z[1]); r[2] = sig1(z[2]); r[3] = sig1(z[3]); return r; }
__device__ __forceinline__ float logsig1(float z) { const float t = __builtin_amdgcn_logf(1.0f + __builtin_amdgcn_exp2f(-LOG2E * fabsf(z))) * 0.6931471805599453f; return (z >= 0.f ? 0.f : z) - t; }
__device__ __forceinline__ float red_fq(float v) { v += __shfl_xor(v, 16); v += __shfl_xor(v, 32); return v; }

#define RSTD8(rs, ssp, row0, invn) float rs[8]; { f32x4 s8_[8]; _Pragma("unroll") for (int i8_ = 0; i8_ < 8; ++i8_) s8_[i8_] = *(const f32x4*)((ssp) + 4 * (size_t)((row0) + (i8_ >> 2) * HALF + (i8_ & 3) * 16)); \
    _Pragma("unroll") for (int i8_ = 0; i8_ < 8; ++i8_) rs[i8_] = __builtin_amdgcn_rsqf(((s8_[i8_][0] + s8_[i8_][1]) + (s8_[i8_][2] + s8_[i8_][3])) * (invn) + RMS_EPS); }
#define EPI_PIN(fr, fq) asm volatile("" : "+v"(fr), "+v"(fq))
struct EpiSwiglu {
    static constexpr bool PERM = true, AFTER_DRAIN = false;
    bf16_t* H; const float* ss; int ldh;
    __device__ __forceinline__ void operator()(const f32x4 (&acc)[2][2][4][2], const Unit& u, int wr, int wc, int fr, int fq) const {
        EPI_PIN(fr, fq);
        const int row0 = u.pm * BM + wr * 64 + fr, col0 = u.pn * 128 + wc * 32 + 8 * fq;
        RSTD8(rs8, ss, row0, 1.0f / 1024.0f);
#pragma unroll
        for (int ai = 0; ai < 2; ++ai)
#pragma unroll
            for (int m = 0; m < 4; ++m) { const int row = row0 + ai * HALF + m * 16; const float rs = rs8[ai * 4 + m];
                f32x4 h[2];
#pragma unroll
                for (int n = 0; n < 2; ++n) { const f32x4 g = acc[ai][0][m][n] * rs, up = acc[ai][1][m][n] * rs; h[n] = g * sig4(g) * up; }
                *(u32x4*)(H + (size_t)row * ldh + col0) = pack8(h[0], h[1]); }
    }
};
template <bool HALF_ALPHA, bool BASE_BF16, bool OUT_AUX>
struct EpiResid {
    static constexpr bool PERM = true, AFTER_DRAIN = true;
    const void* base; float* out; bf16_t* xb; float* ss;
    __device__ __forceinline__ void fused(f32x4 (&acc)[2][2][4][2], const Unit& u, int wr, int wc, int fr, int fq, PG8_LAS unsigned char* lds, int wid, int lane) const {
        EPI_PIN(fr, fq); constexpr float alpha = HALF_ALPHA ? 0.5f : 1.0f;
        PG8_LAS float* P = (PG8_LAS float*)lds;
        const int col0 = u.pn * BM + wc * 32 + 8 * fq;
        u32x4 bv[2][4][2];
        if (BASE_BF16) {
#pragma unroll
            for (int ai = 0; ai < 2; ++ai)
#pragma unroll
                for (int m = 0; m < 4; ++m) { const size_t off = (size_t)(u.pm * BM + ai * HALF + wr * 64 + m * 16 + fr) * 1024 + col0;
#pragma unroll
                    for (int bj = 0; bj < 2; ++bj) bv[ai][m][bj] = *(const u32x4*)((const bf16_t*)base + off + bj * HALF); } }
#pragma unroll
        for (int ai = 0; ai < 2; ++ai)
#pragma unroll
            for (int m = 0; m < 4; ++m) { const int r = ai * HALF + wr * 64 + m * 16 + fr; const size_t off = (size_t)(u.pm * BM + r) * 1024 + col0; float q = 0.f;
#pragma unroll
                for (int bj = 0; bj < 2; ++bj) { const size_t c = off + bj * HALF; f32x4 b0, b1;
                    if (BASE_BF16) unpack8(bv[ai][m][bj], b0, b1); else { b0 = *(const f32x4*)((const float*)base + c); b1 = *(const f32x4*)((const float*)base + c + 4); }
                    const f32x4 o0 = b0 + acc[ai][bj][m][0] * alpha, o1 = b1 + acc[ai][bj][m][1] * alpha;
                    if (OUT_AUX) { q += dot4(o0) + dot4(o1); *(u32x4*)(xb + c) = pack8(o0, o1); } else { *(f32x4*)(out + c) = o0; *(f32x4*)(out + c + 4) = o1; } }
                if (OUT_AUX) { q = red_fq(q); if (fq == 0) P[r * 4 + wc] = q; }
                if (!BASE_BF16 && (m & 1)) asm volatile("" ::: "memory"); }
        if (OUT_AUX) { asm volatile("s_waitcnt lgkmcnt(0)" ::: "memory"); __builtin_amdgcn_s_barrier(); asm volatile("" ::: "memory");
            const int t = wid * 64 + lane;
            if (t < 256) { const f32x4 p = *(const PG8_LAS f32x4*)(P + t * 4); ss[(size_t)(u.pm * BM + t) * 4 + u.pn] = (p[0] + p[1]) + (p[2] + p[3]); } }
    }
};
__device__ __forceinline__ void head_norm_store(const f32x4 (&v)[2][2], const f32x4 (&g)[2][2], float scale, bf16_t* dstrow) {
    float s = (dot4(v[0][0]) + dot4(v[0][1])) + (dot4(v[1][0]) + dot4(v[1][1])); s = red_fq(s);
    const float r2 = __builtin_amdgcn_rsqf(s * (1.0f / 64.0f) + RMS_EPS) * scale;
#pragma unroll
    for (int bj = 0; bj < 2; ++bj) *(u32x4*)(dstrow + 32 * bj) = pack8(v[bj][0] * r2 * g[bj][0], v[bj][1] * r2 * g[bj][1]);
}
__device__ __forceinline__ void rope_norm_store(f32x4 x1, f32x4 x2, f32x4 g1, f32x4 g2, const float* cosr, const float* sinr, int fq, float scale, bf16_t* dst8) {
    float s = dot4(x1) + dot4(x2); s = red_fq(s);
    const float r2 = __builtin_amdgcn_rsqf(s * (1.0f / 32.0f) + RMS_EPS);
    const f32x4 cs = *(const f32x4*)(cosr + 4 * fq), sn = *(const f32x4*)(sinr + 4 * fq);
    x1 = x1 * r2 * g1; x2 = x2 * r2 * g2;
    const f32x4 o1 = (x1 * cs - x2 * sn) * scale, o2 = (x2 * cs + x1 * sn) * scale;
    *(u32x4*)dst8 = pack8(o1, o2);
}
struct EpiWin {
    static constexpr bool PERM = true, AFTER_DRAIN = false;
    unsigned char* ws;
    __device__ __forceinline__ void operator()(const f32x4 (&acc)[2][2][4][2], const Unit& u, int wr, int wc, int fr, int fq) const {
        EPI_PIN(fr, fq);
        const float* ss1 = (const float*)(ws + WS_SS1); const float* par = (const float*)(ws + WS_PAR);
        bf16_t* qlat = (bf16_t*)(ws + WS_QLAT); bf16_t* kvlat = (bf16_t*)(ws + WS_KVLAT); bf16_t* kr = (bf16_t*)(ws + WS_KR);
        float* ssq = (float*)(ws + WS_SSQ); float* sskv = (float*)(ws + WS_SSKV); float* logf = (float*)(ws + WS_LOGF);
        const float* cosT = (const float*)(ws + WS_COS); const float* sinT = (const float*)(ws + WS_SIN);
        const float* krg = par + PAR_KRG; const float* bfp = par + PAR_BF; const float* bg = par + PAR_BG;
        const int row0 = u.pm * BM + wr * 64 + fr, pn = u.pn;
        RSTD8(rs8, ss1, row0, 1.0f / 1024.0f);
        if (pn == 0) {
#pragma unroll
            for (int ai = 0; ai < 2; ++ai)
#pragma unroll
                for (int m = 0; m < 4; ++m) { const int row = row0 + ai * HALF + m * 16; const float rs = rs8[ai * 4 + m]; float q = 0.f;
#pragma unroll
                    for (int bj = 0; bj < 2; ++bj) { const f32x4 a = acc[ai][bj][m][0] * rs, b = acc[ai][bj][m][1] * rs; q += dot4(a) + dot4(b);
                        *(u32x4*)(qlat + (size_t)row * 256 + bj * HALF + wc * 32 + 8 * fq) = pack8(a, b); }
                    q = red_fq(q); if (fq == 0) ssq[(size_t)row * 4 + wc] = q; }
        } else if (pn == 1) {
            const f32x4 g1 = *(const f32x4*)(krg + 4 * fq), g2 = *(const f32x4*)(krg + 16 + 4 * fq);
            const f32x4 b0 = *(const f32x4*)(bfp), b1 = *(const f32x4*)(bfp + 4);
#pragma unroll
            for (int ai = 0; ai < 2; ++ai)
#pragma unroll
                for (int m = 0; m < 4; ++m) { const int row = row0 + ai * HALF + m * 16; const float rs = rs8[ai * 4 + m];
                    const f32x4 a = acc[ai][0][m][0] * rs, b = acc[ai][0][m][1] * rs; float q = dot4(a) + dot4(b);
                    *(u32x4*)(kvlat + (size_t)row * 128 + wc * 32 + 8 * fq) = pack8(a, b);
                    q = red_fq(q); if (fq == 0) sskv[(size_t)row * 4 + wc] = q;
                    if (wc == 0) rope_norm_store(acc[ai][1][m][0] * rs, acc[ai][1][m][1] * rs, g1, g2, cosT + (size_t)row * 16, sinT + (size_t)row * 16, fq, 1.0f, kr + (size_t)row * 32 + 8 * fq);
                    if (wc == 1 && fq == 0) { const f32x4 z0 = acc[ai][1][m][0] * rs + b0, z1 = acc[ai][1][m][1] * rs + b1; f32x4 l0, l1;
#pragma unroll
                        for (int i = 0; i < 4; ++i) { l0[i] = logsig1(z0[i]); l1[i] = logsig1(z1[i]); }
                        *(f32x4*)(logf + (size_t)row * 8) = l0; *(f32x4*)(logf + (size_t)row * 8 + 4) = l1; } }
        } else if (pn < 8) {
            const int kind = (pn - 2) >> 1, head = 4 * ((pn - 2) & 1) + wc;
            bf16_t* dst = (bf16_t*)(ws + (kind == 0 ? WS_QF : kind == 1 ? WS_KF : WS_VF)) + 64 * head + 8 * fq;
            const float* gp = par + (kind == 1 ? PAR_FKG : PAR_FQG) + 8 * fq; f32x4 g[2][2];
#pragma unroll
            for (int bj = 0; bj < 2; ++bj)
#pragma unroll
                for (int n = 0; n < 2; ++n) g[bj][n] = *(const f32x4*)(gp + 32 * bj + 4 * n);
            const float scale = kind == 0 ? C2F : 1.0f;
#pragma unroll
            for (int ai = 0; ai < 2; ++ai)
#pragma unroll
                for (int m = 0; m < 4; ++m) { const int row = row0 + ai * HALF + m * 16; const float rs = rs8[ai * 4 + m]; f32x4 v[2][2];
#pragma unroll
                    for (int bj = 0; bj < 2; ++bj)
#pragma unroll
                        for (int n = 0; n < 2; ++n) v[bj][n] = acc[ai][bj][m][n] * rs;
                    if (kind == 2) {
#pragma unroll
                        for (int bj = 0; bj < 2; ++bj) *(u32x4*)(dst + (size_t)row * 512 + 32 * bj) = pack8(v[bj][0], v[bj][1]);
                    } else head_norm_store(v, g, scale, dst + (size_t)row * 512); }
        } else {
            const int which = (pn - 8) >> 2, colb = 256 * ((pn - 8) & 3) + wc * 32 + 8 * fq; f32x4 bb[2][2];
#pragma unroll
            for (int bj = 0; bj < 2; ++bj)
#pragma unroll
                for (int n = 0; n < 2; ++n) bb[bj][n] = *(const f32x4*)(bg + 1024 * which + colb + bj * HALF + 4 * n);
            bf16_t* dst = (bf16_t*)(ws + WS_GATES) + (size_t)which * 16384 * 1024 + colb;
#pragma unroll
            for (int ai = 0; ai < 2; ++ai)
#pragma unroll
                for (int m = 0; m < 4; ++m) { const int row = row0 + ai * HALF + m * 16; const float rs = rs8[ai * 4 + m];
#pragma unroll
                    for (int bj = 0; bj < 2; ++bj) *(u32x4*)(dst + (size_t)row * 1024 + bj * HALF) = pack8(sig4(acc[ai][bj][m][0] * rs + bb[bj][0]), sig4(acc[ai][bj][m][1] * rs + bb[bj][1])); }
        }
    }
};
struct EpiMlaQ {
    static constexpr bool PERM = true, AFTER_DRAIN = false;
    unsigned char* ws;
    __device__ __forceinline__ void operator()(const f32x4 (&acc)[2][2][4][2], const Unit& u, int wr, int wc, int fr, int fq) const {
        EPI_PIN(fr, fq);
        const float* ssq = (const float*)(ws + WS_SSQ); bf16_t* Qm = (bf16_t*)(ws + WS_QM); const float* gn = (const float*)(ws + WS_PAR) + PAR_QNG; const float* gr = (const float*)(ws + WS_PAR) + PAR_QRG;
        const float* cosT = (const float*)(ws + WS_COS); const float* sinT = (const float*)(ws + WS_SIN);
        const int row0 = u.pm * BM + wr * 64 + fr, pn = u.pn;
        RSTD8(rs8, ssq, row0, 1.0f / 192.0f);
        if (pn < 2) { const int head = 4 * pn + wc; f32x4 g[2][2];
#pragma unroll
            for (int bj = 0; bj < 2; ++bj)
#pragma unroll
                for (int n = 0; n < 2; ++n) g[bj][n] = *(const f32x4*)(gn + 8 * fq + 32 * bj + 4 * n);
#pragma unroll
            for (int ai = 0; ai < 2; ++ai)
#pragma unroll
                for (int m = 0; m < 4; ++m) { const int row = row0 + ai * HALF + m * 16; const float rs = rs8[ai * 4 + m]; f32x4 v[2][2];
#pragma unroll
                    for (int bj = 0; bj < 2; ++bj)
#pragma unroll
                        for (int n = 0; n < 2; ++n) v[bj][n] = acc[ai][bj][m][n] * rs;
                    head_norm_store(v, g, C2M, Qm + (size_t)row * 768 + 96 * head + 8 * fq); }
        } else { const f32x4 g1 = *(const f32x4*)(gr + 4 * fq), g2 = *(const f32x4*)(gr + 16 + 4 * fq);
#pragma unroll
            for (int ai = 0; ai < 2; ++ai)
#pragma unroll
                for (int m = 0; m < 4; ++m) { const int row = row0 + ai * HALF + m * 16; const float rs = rs8[ai * 4 + m];
#pragma unroll
                    for (int bj = 0; bj < 2; ++bj) rope_norm_store(acc[ai][bj][m][0] * rs, acc[ai][bj][m][1] * rs, g1, g2, cosT + (size_t)row * 16, sinT + (size_t)row * 16, fq, C2M,
                                                                   Qm + (size_t)row * 768 + 96 * (wc + 4 * bj) + 64 + 8 * fq); }
        }
    }
};
struct EpiMlaKV {
    static constexpr bool PERM = true, AFTER_DRAIN = false;
    unsigned char* ws; bf16_t* Vm;
    __device__ __forceinline__ void operator()(const f32x4 (&acc)[2][2][4][2], const Unit& u, int wr, int wc, int fr, int fq) const {
        EPI_PIN(fr, fq);
        const float* sskv = (const float*)(ws + WS_SSKV); bf16_t* Km = (bf16_t*)(ws + WS_KM); const float* gn = (const float*)(ws + WS_PAR) + PAR_KNG;
        const int row0 = u.pm * BM + wr * 64 + fr, pn = u.pn, head = 4 * (pn & 1) + wc; f32x4 g[2][2];
        RSTD8(rs8, sskv, row0, 1.0f / 128.0f);
#pragma unroll
        for (int bj = 0; bj < 2; ++bj)
#pragma unroll
            for (int n = 0; n < 2; ++n) g[bj][n] = *(const f32x4*)(gn + 8 * fq + 32 * bj + 4 * n);
#pragma unroll
        for (int ai = 0; ai < 2; ++ai)
#pragma unroll
            for (int m = 0; m < 4; ++m) { const int row = row0 + ai * HALF + m * 16; const float rs = rs8[ai * 4 + m]; f32x4 v[2][2];
#pragma unroll
                for (int bj = 0; bj < 2; ++bj)
#pragma unroll
                    for (int n = 0; n < 2; ++n) v[bj][n] = acc[ai][bj][m][n] * rs;
                if (pn < 2) head_norm_store(v, g, 1.0f, Km + (size_t)row * 512 + 64 * head + 8 * fq);
                else {
#pragma unroll
                    for (int bj = 0; bj < 2; ++bj) *(u32x4*)(Vm + (size_t)row * 512 + 64 * head + 8 * fq + 32 * bj) = pack8(v[bj][0], v[bj][1]); } }
    }
};
struct EpiBranch {
    static constexpr bool PERM = true, AFTER_DRAIN = false, MIDHOOK = true;
    unsigned char* ws;
    __device__ __forceinline__ bool mid(f32x4 (&acc)[2][2][4][2], const Unit& u, int wr, int wc, int fr, int fq) const {
        EPI_PIN(fr, fq);
        const bf16_t* gm = (const bf16_t*)(ws + WS_GATES); const bf16_t* gf = gm + (size_t)16384 * 1024; bf16_t* mixed = (bf16_t*)(ws + WS_MIXED);
        const int which = u.pm >= 64 ? 1 : 0, pm = u.pm - 64 * which, pn = u.pn - 4 * which;
        const int row0 = pm * BM + wr * 64 + fr, col0 = pn * BM + wc * 32 + 8 * fq;
        const f32x4 fl = (f32x4){1e-20f, 1e-20f, 1e-20f, 1e-20f};
        if (!which) {
#pragma unroll
            for (int ai = 0; ai < 2; ++ai)
#pragma unroll
                for (int m = 0; m < 4; ++m) { const size_t off = (size_t)(row0 + ai * HALF + m * 16) * 1024 + col0;
#pragma unroll
                    for (int bj = 0; bj < 2; ++bj) { f32x4 ma, mb, fa, fb; unpack8(*(const u32x4*)(gm + off + bj * HALF), ma, mb); unpack8(*(const u32x4*)(gf + off + bj * HALF), fa, fb);
#pragma unroll
                        for (int i = 0; i < 4; ++i) { acc[ai][bj][m][0][i] *= ma[i] * __builtin_amdgcn_rcpf(fmaxf(fa[i], fl[i])); acc[ai][bj][m][1][i] *= mb[i] * __builtin_amdgcn_rcpf(fmaxf(fb[i], fl[i])); } } }
            return true; }
#pragma unroll
        for (int ai = 0; ai < 2; ++ai)
#pragma unroll
            for (int m = 0; m < 4; ++m) { const size_t off = (size_t)(row0 + ai * HALF + m * 16) * 1024 + col0;
#pragma unroll
                for (int bj = 0; bj < 2; ++bj) { f32x4 fa, fb; unpack8(*(const u32x4*)(gf + off + bj * HALF), fa, fb);
                    f32x4 a = acc[ai][bj][m][0], b = acc[ai][bj][m][1];
#pragma unroll
                    for (int i = 0; i < 4; ++i) { a[i] *= fmaxf(fa[i], fl[i]); b[i] *= fmaxf(fb[i], fl[i]); }
                    *(u32x4*)(mixed + off + bj * HALF) = pack8(a, b); } }
        return false;
    }
};
struct BranchOrder {
    StaticOrder so;
    __device__ void init(int G_, int c_) { so.init(16384, 1024, G_, c_); }
    __device__ bool next(int i, Unit& u) const { Unit t; if (!so.next(i >> 1, t)) return false; const int which = i & 1; u.pm = t.pm + 64 * which; u.pn = t.pn + 4 * which; return true; }
    __device__ __forceinline__ void a_ready(const Unit&) const {}
    __device__ __forceinline__ void done(const Unit&) const {}
};
template <class T, class = void> struct epi_midhook { static constexpr bool value = false; };
template <class T> struct epi_midhook<T, decltype((void)T::MIDHOOK)> { static constexpr bool value = T::MIDHOOK; };
template <class Epi, class Sched, bool ALIGN_EPI = false, bool SP2 = false>
__device__ __forceinline__ void gemm_phase(PG8_LAS unsigned char* lds, const Gemm g, const Sched& S, const Epi& E) {
    const int tid = threadIdx.x, wid = __builtin_amdgcn_readfirstlane(tid >> 6), lane = tid & 63, wr = wid >> 2, wc = wid & 3, fr = lane & 15, fq = lane >> 4;
    const int K = g.K, nt = K / BK;
    unsigned voffA[2], voffB[2];
#pragma unroll
    for (int i = 0; i < 2; ++i) { int R, C; stage_rc(tid * 16 + i * 8192, R, C); const int Rb = Epi::PERM ? ((R & ~31) + perm32(R & 31)) : R;
        voffA[i] = (unsigned)(R * K + C) * 2u; voffB[i] = (unsigned)(Rb * K + C) * 2u; }
    const size_t kstep = (size_t)(BK * 2);
    const size_t hstep = (size_t)HALF * K * 2;
    const size_t tstep = 2 * hstep;
    const unsigned ldsw = (unsigned)wid * 1024u;
    const int aoff = lds_byte(wr * 64 + fr, fq * 8), boff = lds_byte(wc * 32 + fr, fq * 8);
#define PG8_SA(b, h) (((b) * 2 + (h)) * HTB)
#define PG8_SB(b, h) ((4 + (b) * 2 + (h)) * HTB)
#define PG8_STAGE(bufoff, gbase, voff) do { _Pragma("unroll") for (int _i = 0; _i < 2; ++_i) \
        __builtin_amdgcn_global_load_lds((const unsigned*)((const char*)(gbase) + (voff)[_i]), (PG8_LAS unsigned*)(lds + (bufoff) + ldsw + _i * 8192), 16, 0, 0); } while (0)
#define PG8_LDA(dst, b, h) do { _Pragma("unroll") for (int m = 0; m < 4; ++m) _Pragma("unroll") for (int k = 0; k < 2; ++k) dst[m][k] = *(const PG8_LAS bf16x8*)(lds + PG8_SA(b, h) + aoff + m * 2048 + k * 1024); } while (0)
#define PG8_LDB(dst, b, h) do { _Pragma("unroll") for (int n = 0; n < 2; ++n) _Pragma("unroll") for (int k = 0; k < 2; ++k) dst[n][k] = *(const PG8_LAS bf16x8*)(lds + PG8_SB(b, h) + boff + n * 2048 + k * 1024); } while (0)
#define PG8_MMA(ai, bj, At, Bt) do { __builtin_amdgcn_s_setprio(1); _Pragma("unroll") for (int m = 0; m < 4; ++m) _Pragma("unroll") for (int n = 0; n < 2; ++n) _Pragma("unroll") for (int k = 0; k < 2; ++k) \
        acc[ai][bj][m][n] = __builtin_amdgcn_mfma_f32_16x16x32_bf16(Bt[n][k], At[m][k], acc[ai][bj][m][n], 0, 0, 0); __builtin_amdgcn_s_setprio(0); } while (0)
#define PG8_WAIT_V(n) asm volatile("s_waitcnt vmcnt(" #n ")" ::: "memory")
#define PG8_WAIT_L(n) asm volatile("s_waitcnt lgkmcnt(" #n ")" ::: "memory")
#define PG8_BAR __builtin_amdgcn_s_barrier()
#define PG8_SCHED __builtin_amdgcn_sched_barrier(0)
    Unit cur, nxt; int ui = 0;
    if (!S.next(0, cur)) return;
    f32x4 acc[2][2][4][2];
#pragma unroll
    for (int a = 0; a < 2; ++a)
#pragma unroll
        for (int b = 0; b < 2; ++b)
#pragma unroll
            for (int m = 0; m < 4; ++m)
#pragma unroll
                for (int n = 0; n < 2; ++n) acc[a][b][m][n] = (f32x4){0.f, 0.f, 0.f, 0.f};
    bf16x8 At[4][2], B0[2][2], B1[2][2];
    const char* cA = (const char*)g.A + (size_t)cur.pm * tstep; const char* cB = (const char*)g.Bt + (size_t)cur.pn * tstep;
    S.a_ready(cur);
    if constexpr (SP2) {
        PG8_STAGE(PG8_SB(0, 0), cB, voffB); PG8_STAGE(PG8_SB(0, 1), cB + hstep, voffB); PG8_STAGE(PG8_SA(0, 0), cA, voffA); PG8_STAGE(PG8_SA(0, 1), cA + hstep, voffA);
        if (wr == 1) PG8_BAR;
        PG8_WAIT_V(2); PG8_BAR;
        PG8_STAGE(PG8_SB(1, 0), cB + kstep, voffB); PG8_STAGE(PG8_SA(1, 0), cA + kstep, voffA); PG8_STAGE(PG8_SB(1, 1), cB + hstep + kstep, voffB);
        PG8_WAIT_V(6); PG8_BAR;
    } else {
        PG8_STAGE(PG8_SB(0, 0), cB, voffB); PG8_STAGE(PG8_SA(0, 0), cA, voffA); PG8_STAGE(PG8_SB(0, 1), cB + hstep, voffB); PG8_STAGE(PG8_SA(0, 1), cA + hstep, voffA);
        if (wr == 1) PG8_BAR;
        PG8_WAIT_V(4); PG8_BAR;
        PG8_STAGE(PG8_SB(1, 0), cB + kstep, voffB); PG8_STAGE(PG8_SA(1, 0), cA + kstep, voffA); PG8_STAGE(PG8_SB(1, 1), cB + hstep + kstep, voffB);
        PG8_WAIT_V(6); PG8_BAR;
    }
    PRB_T0();
    for (;;) {
        const bool has_next = S.next(ui + 1, nxt);
        const char* nA = has_next ? (const char*)g.A + (size_t)nxt.pm * tstep : cA; const char* nB = has_next ? (const char*)g.Bt + (size_t)nxt.pn * tstep : cB;
        for (int t = 0; t < nt; t += 2) {
            const bool last = (t == nt - 2);
            const char* a1 = cA + (size_t)(t + 1) * kstep;
            const char* a2 = last ? nA : cA + (size_t)(t + 2) * kstep; const char* b2 = last ? nB : cB + (size_t)(t + 2) * kstep;
            const char* a3 = a2 + kstep; const char* b3 = b2 + kstep;
            if (last && has_next) S.a_ready(nxt);
            if constexpr (SP2) {
            PG8_LDB(B0, 0, 0); PG8_LDB(B1, 0, 1); PG8_SCHED; PG8_LDA(At, 0, 0); PG8_STAGE(PG8_SA(1, 1), a1 + hstep, voffA);
            PG8_WAIT_V(8); PG8_WAIT_L(0); PG8_BAR; PG8_MMA(0, 0, At, B0); PG8_MMA(0, 1, At, B1); PG8_BAR; PG8_SCHED;
            PG8_LDA(At, 0, 1); PG8_STAGE(PG8_SB(0, 0), b2, voffB); PG8_STAGE(PG8_SB(0, 1), b2 + hstep, voffB); PG8_STAGE(PG8_SA(0, 0), a2, voffA);
            PG8_WAIT_V(8); PG8_WAIT_L(0); PG8_BAR; PG8_MMA(1, 0, At, B0); PG8_MMA(1, 1, At, B1); PG8_BAR; PG8_SCHED;
            PG8_LDB(B0, 1, 0); PG8_LDB(B1, 1, 1); PG8_SCHED; PG8_LDA(At, 1, 0); PG8_STAGE(PG8_SA(0, 1), a2 + hstep, voffA);
            PG8_WAIT_V(8); PG8_WAIT_L(0); PG8_BAR; PG8_MMA(0, 0, At, B0); PG8_MMA(0, 1, At, B1); PG8_BAR; PG8_SCHED;
            PG8_LDA(At, 1, 1); PG8_STAGE(PG8_SB(1, 0), b3, voffB); PG8_STAGE(PG8_SB(1, 1), b3 + hstep, voffB); PG8_STAGE(PG8_SA(1, 0), a3, voffA);
            PG8_WAIT_V(8); PG8_WAIT_L(0); PG8_BAR; PG8_MMA(1, 0, At, B0); PG8_MMA(1, 1, At, B1); PG8_BAR; PG8_SCHED;
            } else {
            PG8_LDB(B0, 0, 0); PG8_SCHED; PG8_LDA(At, 0, 0); PG8_STAGE(PG8_SA(1, 1), a1 + hstep, voffA);
            PG8_WAIT_L(8); PG8_BAR; PG8_WAIT_L(0); PG8_MMA(0, 0, At, B0); PG8_BAR; PG8_SCHED;
            PG8_LDB(B1, 0, 1); PG8_STAGE(PG8_SB(0, 0), b2, voffB);
            PG8_BAR; PG8_WAIT_L(0); PG8_MMA(0, 1, At, B1); PG8_BAR;
            PG8_LDA(At, 0, 1); PG8_STAGE(PG8_SA(0, 0), a2, voffA);
            PG8_BAR; PG8_WAIT_L(0); PG8_MMA(1, 0, At, B0); PG8_BAR; PG8_SCHED;
            PG8_STAGE(PG8_SB(0, 1), b2 + hstep, voffB);
            PG8_WAIT_V(6); PG8_BAR; PG8_MMA(1, 1, At, B1); PG8_BAR;
            PG8_LDB(B0, 1, 0); PG8_SCHED; PG8_LDA(At, 1, 0); PG8_STAGE(PG8_SA(0, 1), a2 + hstep, voffA);
            PG8_WAIT_L(8); PG8_BAR; PG8_WAIT_L(0); PG8_MMA(0, 0, At, B0); PG8_BAR; PG8_SCHED;
            PG8_LDB(B1, 1, 1); PG8_STAGE(PG8_SB(1, 0), b3, voffB);
            PG8_BAR; PG8_WAIT_L(0); PG8_MMA(0, 1, At, B1); PG8_BAR;
            PG8_LDA(At, 1, 1); PG8_STAGE(PG8_SA(1, 0), a3, voffA);
            PG8_BAR; PG8_WAIT_L(0); PG8_MMA(1, 0, At, B0); PG8_BAR; PG8_SCHED;
            PG8_STAGE(PG8_SB(1, 1), b3 + hstep, voffB);
            PG8_WAIT_V(6); PG8_BAR; PG8_MMA(1, 1, At, B1); PG8_BAR;
            }
        }
        if constexpr (ALIGN_EPI) { if (wr == 0) PG8_BAR; }
        bool keep_acc = false;
        PRB_ACC_IF(4); if constexpr (!Epi::AFTER_DRAIN) { if constexpr (epi_midhook<Epi>::value) keep_acc = E.mid(acc, cur, wr, wc, fr, fq); else E(acc, cur, wr, wc, fr, fq); S.done(cur); } PRB_ACC_IF(3);
        if (!has_next) break;
        if (!keep_acc)
#pragma unroll
        for (int a = 0; a < 2; ++a)
#pragma unroll
            for (int b = 0; b < 2; ++b)
#pragma unroll
                for (int m = 0; m < 4; ++m)
#pragma unroll
                    for (int n = 0; n < 2; ++n) acc[a][b][m][n] = (f32x4){0.f, 0.f, 0.f, 0.f};
        cur = nxt; cA = nA; cB = nB; ++ui;
        if constexpr (ALIGN_EPI) { if (wr == 1) PG8_BAR; }
    }
    PG8_WAIT_V(0);
    if constexpr (!ALIGN_EPI) { if (wr == 0) PG8_BAR; }
    PG8_BAR;
    PRB_ACC_IF(4); if constexpr (Epi::AFTER_DRAIN) { E.fused(acc, cur, wr, wc, fr, fq, lds, wid, lane); S.done(cur); } PRB_ACC_IF(3);
#undef PG8_SA
#undef PG8_SB
#undef PG8_STAGE
#undef PG8_LDA
#undef PG8_LDB
#undef PG8_MMA
#undef PG8_WAIT_V
#undef PG8_WAIT_L
#undef PG8_BAR
#undef PG8_SCHED
}
}
namespace att {
#define ALAS __attribute__((address_space(3)))
typedef short bf16x8 __attribute__((ext_vector_type(8)));
typedef short s16x4 __attribute__((ext_vector_type(4)));
typedef float f32x16 __attribute__((ext_vector_type(16)));
typedef float f32x4 __attribute__((ext_vector_type(4)));
typedef unsigned u32x4 __attribute__((ext_vector_type(4)));
typedef unsigned short bf16_t;
constexpr int SEQ = 4096, QB = 256, KVB = 64;
constexpr int L_K = 0, L_V = 49152, L_WS = 81920, L_OST = 83968, L_END = 116736;
constexpr float THR = 20.0f;
__device__ __forceinline__ int crow(int r, int hi) { return (r & 3) + 8 * (r >> 2) + 4 * hi; }
__device__ __forceinline__ unsigned cvtpk(float lo, float hi) { return pg8::cvt_pk_bf16(lo, hi); }
__device__ __forceinline__ float addf(float a, float b) { float r; asm("v_add_f32 %0, %1, %2" : "=v"(r) : "v"(a), "v"(b)); return r; }
__device__ __forceinline__ s16x4 vtr(const ALAS char* p) { typedef short v4i16_t __attribute__((ext_vector_type(4))); return __builtin_bit_cast(s16x4, __builtin_amdgcn_ds_read_tr16_b64_v4i16((ALAS v4i16_t*)p)); }

template <int NKS, bool QONE, int QP, int QH, int KP, int KXP, int KXH, int VP, int OP, int ABL = 0>
__device__ __forceinline__ void attn_unit(int b, int h, int qb, const bf16_t* Q, const bf16_t* K, const bf16_t* KX, const bf16_t* V, bf16_t* O, ALAS char* shm) {
    int tid = threadIdx.x; asm volatile("" : "+v"(tid));
    const int lane = tid & 63, r32 = lane & 31, hi = lane >> 5; const int wid = __builtin_amdgcn_readfirstlane(tid >> 6);
    const long tok0 = (long)b * SEQ; const int q0 = qb * QB, NT = (q0 + QB) / KVB;
    bf16x8 qr[NKS];
    { const bf16_t* Qw = Q + (tok0 + q0 + wid * 32 + r32) * QP + h * QH;
#pragma unroll
      for (int ks = 0; ks < (QONE ? NKS - 1 : NKS); ++ks) qr[ks] = *(const bf16x8*)(Qw + ks * 16 + hi * 8);
      if (QONE) { const short one = hi ? (short)0 : (short)0x3F80; qr[NKS - 1] = (bf16x8){one, one, one, 0, 0, 0, 0, 0}; } }
#define QPIN() do { _Pragma("unroll") for (int ks = 0; ks < NKS; ++ks) asm volatile("s_waitcnt vmcnt(0)" : "+v"(qr[ks]) :: "memory"); } while (0)
    const int kr1 = 4 * wid + (lane >> 4), kc = (lane & 15) ^ (kr1 & 15); const bool kact = kc < 2 * NKS;
    const bf16_t* ksrc = K + (tok0 + kr1) * KP + h * 64 + kc * 8; int kstep = KP;
    if (kc >= 8) { ksrc = KX + (tok0 + kr1) * KXP + h * KXH + (kc - 8) * 8; kstep = KXP; }
    const bf16_t* vsrc = V + (tok0 + 16 * (wid & 3) + (lane >> 2)) * VP + h * 64 + (wid >> 2) * 32 + (lane & 3) * 8;
    const unsigned lds0 = (unsigned)(uintptr_t)shm;
    const unsigned kdst = lds0 + L_K + wid * 1024, vdst = lds0 + L_V + wid * 1024;
#define GLDS16(gp, dst) do { unsigned keep_; asm volatile("s_mov_b32 %0, m0\n\ts_mov_b32 m0, %2\n\ts_nop 0\n\tglobal_load_lds_dwordx4 %1, off\n\ts_mov_b32 m0, %0" : "=&s"(keep_) : "v"(gp), "s"((unsigned)__builtin_amdgcn_readfirstlane(dst)) : "memory"); } while (0)
    const bf16_t* kp_a = ksrc; const bf16_t* kp_b = ksrc + 32 * kstep; const bf16_t* vp_a = vsrc; const int kinc = 64 * kstep;
#define DMA_KA(ksl) do { if (kact) GLDS16(kp_a, kdst + (ksl) * 16384); kp_a += kinc; } while (0)
#define DMA_KB(ksl) do { if (kact) GLDS16(kp_b, kdst + (ksl) * 16384 + 8192); kp_b += kinc; } while (0)
#define DMA_V(vsl) do { GLDS16(vp_a, vdst + (vsl)); vp_a += 64 * VP; } while (0)
#define LOADT(t, ksl, vsl) do {   DMA_KA(ksl); DMA_KB(ksl); DMA_V(vsl); } while (0)
#define TILE_SYNC(inflight) do { if (inflight) asm volatile("s_waitcnt vmcnt(3) lgkmcnt(0)" ::: "memory"); else asm volatile("s_waitcnt vmcnt(0) lgkmcnt(0)" ::: "memory"); PRB_ACC(1); \
        __builtin_amdgcn_s_barrier(); asm volatile("" ::: "memory"); } while (0)
    int kra[NKS];
#pragma unroll
    for (int ks = 0; ks < NKS; ++ks) kra[ks] = L_K + r32 * 256 + (((2 * ks + hi) ^ (r32 & 15)) << 4);
    const int vrb = L_V + ((lane >> 4) & 1) * 32 + (lane & 3) * 8 + (4 * hi + ((lane & 15) >> 2)) * 64;
    ALAS float* wsf = (ALAS float*)(shm + L_WS) + wid * 64;
    const int qrel = wid * 32 + r32;
    float zf_ = 0.f; asm volatile("" : "+v"(zf_));
    float m_run = 0.f, l_run = 0.f; f32x16 o[2], negm;
#pragma unroll
    for (int r = 0; r < 16; ++r) { o[0][r] = zf_; o[1][r] = zf_; negm[r] = zf_; }
    asm volatile("" : "+v"(negm));
    f32x16 p0, p1; bf16x8 vf[8]; u32x4 pw[4];
#define ACT(t) (((t) < NT - 4) || (64 * ((t) - (NT - 4)) <= 32 * wid + 31))
#define SB() __builtin_amdgcn_sched_barrier(0)
#define SMH(P, PEND, HAS_PEND, HALFI, FIRST) do { \
        float a_ = fmaxf(fmaxf(P[0], P[1]), P[2]), b_ = fmaxf(fmaxf(P[3], P[4]), P[5]); a_ = fmaxf(fmaxf(a_, P[6]), P[7]); b_ = fmaxf(fmaxf(b_, P[8]), P[9]); \
        a_ = fmaxf(fmaxf(a_, P[10]), P[11]); b_ = fmaxf(fmaxf(b_, P[12]), P[13]); a_ = fmaxf(fmaxf(a_, P[14]), P[15]); \
        float mx_ = fmaxf(a_, b_); { auto rr_ = __builtin_amdgcn_permlane32_swap(__float_as_uint(mx_), __float_as_uint(mx_), false, false); mx_ = fmaxf(__uint_as_float(rr_[0]), __uint_as_float(rr_[1])); } \
        const bool need_ = (FIRST) || (mx_ > THR); \
        if (__any(need_)) { const float dl_ = need_ ? mx_ : 0.f; m_run += dl_; const float al_ = __builtin_amdgcn_exp2f(-dl_); l_run *= al_; \
            _Pragma("unroll") for (int r = 0; r < 16; ++r) { P[r] -= dl_; if (HAS_PEND) PEND[r] -= dl_; negm[r] = -m_run; } asm volatile("" : "+v"(negm)); \
            if (hi == 0) wsf[r32] = al_; asm volatile("s_waitcnt lgkmcnt(0)" ::: "memory"); \
            _Pragma("unroll") for (int g = 0; g < 4; ++g) { const f32x4 av_ = *(const ALAS f32x4*)(wsf + 8 * g + 4 * hi); \
                _Pragma("unroll") for (int i = 0; i < 4; ++i) { o[0][4 * g + i] *= av_[i]; o[1][4 * g + i] *= av_[i]; } } } \
        if (ABL != 1 && ABL != 6) { _Pragma("unroll") for (int r = 0; r < 16; ++r) P[r] = __builtin_amdgcn_exp2f(P[r]); } \
        if (ABL != 1 && ABL != 6) { float s0_ = addf(P[0], P[1]), s1_ = addf(P[2], P[3]), s2_ = addf(P[4], P[5]), s3_ = addf(P[6], P[7]); s0_ = addf(s0_, addf(P[8], P[9])); s1_ = addf(s1_, addf(P[10], P[11])); s2_ = addf(s2_, addf(P[12], P[13])); s3_ = addf(s3_, addf(P[14], P[15])); l_run = addf(l_run, addf(addf(s0_, s1_), addf(s2_, s3_))); } \
        _Pragma("unroll") for (int s = 0; s < 2; ++s) pw[2 * (HALFI) + s] = (u32x4){cvtpk(P[8 * s], P[8 * s + 1]), cvtpk(P[8 * s + 2], P[8 * s + 3]), cvtpk(P[8 * s + 4], P[8 * s + 5]), cvtpk(P[8 * s + 6], P[8 * s + 7])}; } while (0)
#define PVH(HALFI) do { if (ABL == 2) { asm volatile("" :: "v"(pw[2 * (HALFI)]), "v"(pw[2 * (HALFI) + 1])); } else _Pragma("unroll") for (int ks = 2 * (HALFI); ks < 2 * (HALFI) + 2; ++ks) _Pragma("unroll") for (int d0 = 0; d0 < 2; ++d0) \
        o[d0] = __builtin_amdgcn_mfma_f32_32x32x16_bf16(__builtin_bit_cast(bf16x8, pw[ks]), vf[2 * ks + d0], o[d0], 0, 0, 0); } while (0)
#define TILE(t, ksl, vsl, DIAG, EMB, ksl2, vsl2) do { if (!(DIAG) || ACT(t)) { const ALAS char* kp_ = (const ALAS char*)shm + (ksl) * 16384; const ALAS char* vp_ = (const ALAS char*)shm + (vrb + (vsl)); \
        bf16x8 ka_[NKS], kb_[NKS]; \
        _Pragma("unroll") for (int ks = 0; ks < NKS; ++ks) ka_[ks] = *(const ALAS bf16x8*)(kp_ + kra[ks]); \
        _Pragma("unroll") for (int ks = 0; ks < NKS; ++ks) kb_[ks] = *(const ALAS bf16x8*)(kp_ + kra[ks] + 8192); \
        _Pragma("unroll") for (int ks = 0; ks < 4; ++ks) _Pragma("unroll") for (int d0 = 0; d0 < 2; ++d0) { const s16x4 lo_ = vtr(vp_ + d0 * 4096 + ks * 1024), hh_ = vtr(vp_ + d0 * 4096 + ks * 1024 + 512); \
            vf[2 * ks + d0] = (bf16x8){lo_[0], lo_[1], lo_[2], lo_[3], hh_[0], hh_[1], hh_[2], hh_[3]}; } \
        SB(); \
        p0 = __builtin_amdgcn_mfma_f32_32x32x16_bf16(ka_[0], qr[0], negm, 0, 0, 0); \
        p0 = __builtin_amdgcn_mfma_f32_32x32x16_bf16(ka_[1], qr[1], p0, 0, 0, 0); \
        if (EMB) { SB(); DMA_KA(ksl2); SB(); }     \
        _Pragma("unroll") for (int ks = 2; ks < NKS; ++ks) p0 = __builtin_amdgcn_mfma_f32_32x32x16_bf16(ka_[ks], qr[ks], p0, 0, 0, 0); \
        if (EMB) { SB(); DMA_KB(ksl2); SB(); } \
        p1 = __builtin_amdgcn_mfma_f32_32x32x16_bf16(kb_[0], qr[0], negm, 0, 0, 0); \
        p1 = __builtin_amdgcn_mfma_f32_32x32x16_bf16(kb_[1], qr[1], p1, 0, 0, 0); \
        p1 = __builtin_amdgcn_mfma_f32_32x32x16_bf16(kb_[2], qr[2], p1, 0, 0, 0); \
        if (EMB) { SB(); DMA_V(vsl2); SB(); } \
        _Pragma("unroll") for (int ks = 3; ks < NKS; ++ks) p1 = __builtin_amdgcn_mfma_f32_32x32x16_bf16(kb_[ks], qr[ks], p1, 0, 0, 0); \
        const int jb_ = (t) - (NT - 4); const bool dmask_ = (DIAG) && 64 * jb_ + 63 > 32 * wid; \
        if (dmask_) { const float NEG = -__builtin_inff(); const int kbm_ = 64 * jb_ + 4 * hi; \
            _Pragma("unroll") for (int r = 0; r < 16; ++r) { const int kv = kbm_ + (r & 3) + 8 * (r >> 2); if (kv > qrel) p0[r] = NEG; if (kv + 32 > qrel) p1[r] = NEG; } } \
        SMH(p0, p1, true, 0, (t) == 0); \
        PVH(0); \
        SMH(p1, p0, false, 1, false); \
        PVH(1); } } while (0)
#define ROT() do { ks_cur = ks_n1; ks_n1 = ks_n2; ks_n2 = (ks_n2 == 2) ? 0 : ks_n2 + 1; } while (0)
#define VS(t) (((t) & 3) * 8192)
    int ks_cur = 0, ks_n1 = 1, ks_n2 = 2;
    QPIN(); PRB_T0(); LOADT(0, 0, VS(0)); LOADT(1, 1, VS(1)); TILE_SYNC(true);
    int t = 0;
    for (; t < NT - 4; ++t) {
        PRB_RE(); TILE(t, ks_cur, VS(t), false, true, ks_n2, VS(t + 2)); PRB_ACC(0);
        TILE_SYNC(true); PRB_ACC(2); ROT();
    }
    for (; t < NT; ++t) {
        if (t + 2 < NT) LOADT(t + 2, ks_n2, VS(t + 2));
        PRB_RE(); TILE(t, ks_cur, VS(t), true, false, 0, 0); PRB_ACC(0);
        TILE_SYNC(t + 2 < NT); PRB_ACC(2); ROT();
    }
#undef VS
#undef QPIN
#undef LOADT
#undef DMA_KA
#undef DMA_KB
#undef DMA_V
#undef GLDS16
#undef TILE_SYNC
#undef ACT
#undef SB
#undef SMH
#undef PVH
#undef TILE
#undef ROT
    { auto rr = __builtin_amdgcn_permlane32_swap(__float_as_uint(l_run), __float_as_uint(l_run), false, false); l_run = __uint_as_float(rr[0]) + __uint_as_float(rr[1]); }
    if (hi == 0) wsf[32 + r32] = l_run; asm volatile("s_waitcnt lgkmcnt(0)" ::: "memory");
    float rli[16];
#pragma unroll
    for (int g = 0; g < 4; ++g) { const f32x4 a = *(const ALAS f32x4*)(wsf + 32 + 8 * g + 4 * hi);
#pragma unroll
        for (int i = 0; i < 4; ++i) rli[4 * g + i] = __builtin_amdgcn_rcpf(a[i]); }
    bf16_t* Ow = O + (tok0 + q0 + wid * 32) * OP + h * 64;
    { ALAS bf16_t* stg = (ALAS bf16_t*)(shm + L_OST) + wid * 2048;
#pragma unroll
      for (int r = 0; r < 16; ++r) { const int orow = crow(r, hi);
#pragma unroll
          for (int d0 = 0; d0 < 2; ++d0) stg[orow * 64 + d0 * 32 + r32] = (bf16_t)(cvtpk(o[d0][r] * rli[r], 0.f) & 0xffffu); }
      asm volatile("s_waitcnt lgkmcnt(0)" ::: "memory");
#pragma unroll
      for (int i = 0; i < 4; ++i) { const int row = i * 8 + (lane >> 3), ch = lane & 7; const u32x4 v = *(const ALAS u32x4*)(stg + row * 64 + ch * 8); *(u32x4*)(Ow + (long)row * OP + ch * 8) = v; } }
}
template <int NKS, bool QONE, int QP, int QH, int KP, int KXP, int KXH, int VP, int OP, int ABL9 = 0>
__device__ __forceinline__ void attn_unit9(int b, int h, int qb, const bf16_t* Q, const bf16_t* K, const bf16_t* KX, const bf16_t* V, bf16_t* O, ALAS char* shm) {
    int tid = threadIdx.x; asm volatile("" : "+v"(tid));
    const int lane = tid & 63, r32 = lane & 31, hi = lane >> 5; const int wid = __builtin_amdgcn_readfirstlane(tid >> 6);
    const long tok0 = (long)b * SEQ; const int q0 = qb * QB, NT = (q0 + QB) / KVB;
    bf16x8 qr[NKS];
    { const bf16_t* Qw = Q + (tok0 + q0 + wid * 32 + r32) * QP + h * QH;
#pragma unroll
      for (int ks = 0; ks < (QONE ? NKS - 1 : NKS); ++ks) qr[ks] = *(const bf16x8*)(Qw + ks * 16 + hi * 8);
      if (QONE) { const short one = hi ? (short)0 : (short)0x3F80; qr[NKS - 1] = (bf16x8){one, one, one, 0, 0, 0, 0, 0}; } }
#define QPIN() do { _Pragma("unroll") for (int ks = 0; ks < NKS; ++ks) asm volatile("s_waitcnt vmcnt(0)" : "+v"(qr[ks]) :: "memory"); } while (0)
    const int kr1 = 4 * wid + (lane >> 4), kc = (lane & 15) ^ (kr1 & 15); const bool kact = kc < 2 * NKS;
    const bf16_t* ksrc = K + (tok0 + kr1) * KP + h * 64 + kc * 8; int kstep = KP;
    if (kc >= 8) { ksrc = KX + (tok0 + kr1) * KXP + h * KXH + (kc - 8) * 8; kstep = KXP; }
    const bf16_t* vsrc = V + (tok0 + 16 * (wid & 3) + (lane >> 2)) * VP + h * 64 + (wid >> 2) * 32 + (lane & 3) * 8;
    const unsigned lds0 = (unsigned)(uintptr_t)shm;
    const unsigned kdst = lds0 + L_K + wid * 1024, vdst = lds0 + L_V + wid * 1024;
#define GLDS16(gp, dst) do { unsigned keep_; asm volatile("s_mov_b32 %0, m0\n\ts_mov_b32 m0, %2\n\ts_nop 0\n\tglobal_load_lds_dwordx4 %1, off\n\ts_mov_b32 m0, %0" : "=&s"(keep_) : "v"(gp), "s"((unsigned)__builtin_amdgcn_readfirstlane(dst)) : "memory"); } while (0)
    const bf16_t* kp_a = ksrc; const bf16_t* kp_b = ksrc + 32 * kstep; const bf16_t* vp_a = vsrc; const int kinc = 64 * kstep;
#define DMA_KA(ksl) do { if (kact) GLDS16(kp_a, kdst + (ksl) * 16384); kp_a += kinc; } while (0)
#define DMA_KB(ksl) do { if (kact) GLDS16(kp_b, kdst + (ksl) * 16384 + 8192); kp_b += kinc; } while (0)
#define DMA_V(vsl) do { GLDS16(vp_a, vdst + (vsl)); vp_a += 64 * VP; } while (0)
#define LOADT(t, ksl, vsl) do {   DMA_KA(ksl); DMA_KB(ksl); DMA_V(vsl); } while (0)
#define TILE_SYNC(inflight) do { if (inflight) asm volatile("s_waitcnt vmcnt(3) lgkmcnt(0)" ::: "memory"); else asm volatile("s_waitcnt vmcnt(0) lgkmcnt(0)" ::: "memory"); PRB_ACC(1); \
        __builtin_amdgcn_s_barrier(); asm volatile("" ::: "memory"); } while (0)
    int kra[NKS];
#pragma unroll
    for (int ks = 0; ks < NKS; ++ks) kra[ks] = L_K + r32 * 256 + (((2 * ks + hi) ^ (r32 & 15)) << 4);
    const int vrb = L_V + ((lane >> 4) & 1) * 32 + (lane & 3) * 8 + (4 * hi + ((lane & 15) >> 2)) * 64;
    ALAS float* wsf = (ALAS float*)(shm + L_WS) + wid * 64;
    const int qrel = wid * 32 + r32;
    float zf_ = 0.f; asm volatile("" : "+v"(zf_));
    float m_run = 0.f, l_run = 0.f; f32x16 o[2];
#pragma unroll
    for (int r = 0; r < 16; ++r) { o[0][r] = zf_; o[1][r] = zf_; }
    f32x16 pA0, pA1, pB0, pB1; u32x4 pw[4];
#define ACT(t) (((t) < NT - 4) || (64 * ((t) - (NT - 4)) <= 32 * wid + 31))
#define SB() __builtin_amdgcn_sched_barrier(0)
#define SGB(mask, n) __builtin_amdgcn_sched_group_barrier(mask, n, 0)
#define KFRAG(dst, rh, ksl) do { const ALAS char* kp_ = (const ALAS char*)shm + (ksl) * 16384 + (rh) * 8192; _Pragma("unroll") for (int ks = 0; ks < NKS; ++ks) dst[ks] = *(const ALAS bf16x8*)(kp_ + kra[ks]); } while (0)
#define QKCHAIN(P, kf) do { P = __builtin_amdgcn_mfma_f32_32x32x16_bf16(kf[0], qr[0], f32x16{}, 0, 0, 0); \
        _Pragma("unroll") for (int ks = 1; ks < NKS; ++ks) P = __builtin_amdgcn_mfma_f32_32x32x16_bf16(kf[ks], qr[ks], P, 0, 0, 0); } while (0)
#define MASK2(P0, P1, t) do { const int jb_ = (t) - (NT - 4); if (jb_ >= 0 && 64 * jb_ + 63 > 32 * wid) { const float NEG = -__builtin_inff(); const int kbm_ = 64 * jb_ + 4 * hi; \
        _Pragma("unroll") for (int r = 0; r < 16; ++r) { const int kv = kbm_ + (r & 3) + 8 * (r >> 2); if (kv > qrel) P0[r] = NEG; if (kv + 32 > qrel) P1[r] = NEG; } } } while (0)
#define DECIDE2(C0, C1, FIRST) do { \
        float a_ = fmaxf(fmaxf(C0[0], C0[1]), C1[0]), b_ = fmaxf(fmaxf(C0[2], C0[3]), C1[1]); a_ = fmaxf(fmaxf(a_, C1[2]), C1[3]); \
        _Pragma("unroll") for (int r = 4; r < 16; r += 4) { a_ = fmaxf(fmaxf(a_, C0[r]), C0[r + 1]); b_ = fmaxf(fmaxf(b_, C0[r + 2]), C0[r + 3]); a_ = fmaxf(fmaxf(a_, C1[r]), C1[r + 1]); b_ = fmaxf(fmaxf(b_, C1[r + 2]), C1[r + 3]); } \
        float mx_ = fmaxf(a_, b_); { auto rr_ = __builtin_amdgcn_permlane32_swap(__float_as_uint(mx_), __float_as_uint(mx_), false, false); mx_ = fmaxf(__uint_as_float(rr_[0]), __uint_as_float(rr_[1])); } \
        const bool need_ = (FIRST) || (mx_ > m_run + THR); \
        if (__any(need_)) { const float al_ = need_ ? __builtin_amdgcn_exp2f(m_run - mx_) : 1.0f; if (FIRST) l_run = 0.f; else l_run *= al_; m_run = need_ ? mx_ : m_run; \
            if (hi == 0) wsf[r32] = (FIRST) ? 1.0f : al_; asm volatile("s_waitcnt lgkmcnt(0)" ::: "memory"); \
            _Pragma("unroll") for (int g = 0; g < 4; ++g) { const f32x4 av_ = *(const ALAS f32x4*)(wsf + 8 * g + 4 * hi); \
                _Pragma("unroll") for (int i = 0; i < 4; ++i) { o[0][4 * g + i] *= av_[i]; o[1][4 * g + i] *= av_[i]; } } } } while (0)
#define EXPSUMPACK(C0, C1) do { _Pragma("unroll") for (int r = 0; r < 16; ++r) { C0[r] = __builtin_amdgcn_exp2f(C0[r] - m_run); C1[r] = __builtin_amdgcn_exp2f(C1[r] - m_run); } \
        float s0_ = addf(C0[0], C1[0]), s1_ = addf(C0[1], C1[1]), s2_ = addf(C0[2], C1[2]), s3_ = addf(C0[3], C1[3]); \
        _Pragma("unroll") for (int r = 4; r < 16; r += 4) { s0_ = addf(s0_, addf(C0[r], C1[r])); s1_ = addf(s1_, addf(C0[r + 1], C1[r + 1])); s2_ = addf(s2_, addf(C0[r + 2], C1[r + 2])); s3_ = addf(s3_, addf(C0[r + 3], C1[r + 3])); } \
        l_run = addf(l_run, addf(addf(s0_, s1_), addf(s2_, s3_))); \
        _Pragma("unroll") for (int s = 0; s < 2; ++s) { pw[s] = (u32x4){cvtpk(C0[8 * s], C0[8 * s + 1]), cvtpk(C0[8 * s + 2], C0[8 * s + 3]), cvtpk(C0[8 * s + 4], C0[8 * s + 5]), cvtpk(C0[8 * s + 6], C0[8 * s + 7])}; \
            pw[2 + s] = (u32x4){cvtpk(C1[8 * s], C1[8 * s + 1]), cvtpk(C1[8 * s + 2], C1[8 * s + 3]), cvtpk(C1[8 * s + 4], C1[8 * s + 5]), cvtpk(C1[8 * s + 6], C1[8 * s + 7])}; } } while (0)
#define PV8(vsl) do { const ALAS char* vp_ = (const ALAS char*)shm + (vrb + (vsl)); \
        _Pragma("unroll") for (int ks = 0; ks < 4; ++ks) _Pragma("unroll") for (int d0 = 0; d0 < 2; ++d0) { const s16x4 lo_ = vtr(vp_ + d0 * 4096 + ks * 1024), hh_ = vtr(vp_ + d0 * 4096 + ks * 1024 + 512); \
            const bf16x8 vf_ = (bf16x8){lo_[0], lo_[1], lo_[2], lo_[3], hh_[0], hh_[1], hh_[2], hh_[3]}; \
            o[d0] = __builtin_amdgcn_mfma_f32_32x32x16_bf16(__builtin_bit_cast(bf16x8, pw[ks]), vf_, o[d0], 0, 0, 0); } } while (0)
#define STEP9(C0, C1, N0, N1, t, ksl_next, DIAG, HASNEXT) do { if (!(DIAG) || ACT(t)) { \
        const bool nx_ = (HASNEXT) && (!(DIAG) || ACT((t) + 1)); bf16x8 kf_[NKS]; \
        if (!(DIAG) && nx_) { KFRAG(kf_, 0, ksl_next); } \
        DECIDE2(C0, C1, (t) == 0); SB(); \
        if ((DIAG) && nx_) { KFRAG(kf_, 0, ksl_next); } \
        if (nx_) { EXPSUMPACK(C0, C1); QKCHAIN(N0, kf_); SB(); KFRAG(kf_, 1, ksl_next); QKCHAIN(N1, kf_); SB(); \
            if (DIAG) MASK2(N0, N1, (t) + 1); } \
        else { EXPSUMPACK(C0, C1); SB(); } \
        PV8(VS(t)); SB(); } } while (0)
#define ROT() do { ks_cur = ks_n1; ks_n1 = ks_n2; ks_n2 = (ks_n2 == 2) ? 0 : ks_n2 + 1; } while (0)
#define VS(t) (((t) & 3) * 8192)
#define SYNC9(n) do { asm volatile("s_waitcnt vmcnt(" #n ") lgkmcnt(0)" ::: "memory"); __builtin_amdgcn_s_barrier(); asm volatile("" ::: "memory"); } while (0)
    int ks_cur = 0, ks_n1 = 1, ks_n2 = 2;
    QPIN();
    DMA_KA(0); DMA_KB(0); DMA_V(VS(0)); DMA_KA(1); DMA_KB(1); DMA_V(VS(1)); DMA_KA(2); DMA_KB(2);
    SYNC9(6);
    { bf16x8 kf_[NKS]; KFRAG(kf_, 0, 0); QKCHAIN(pA0, kf_); SB(); KFRAG(kf_, 1, 0); QKCHAIN(pA1, kf_); MASK2(pA0, pA1, 0); }
    SYNC9(3);
    ks_cur = 1; ks_n1 = 2; ks_n2 = 0;
    int t = 0;
    for (; t + 2 < NT - 4; t += 2) {
        DMA_KA(ks_n2); DMA_KB(ks_n2); DMA_V(VS(t + 2));
        STEP9(pA0, pA1, pB0, pB1, t, ks_cur, false, true); SYNC9(3); ROT();
        DMA_KA(ks_n2); DMA_KB(ks_n2); DMA_V(VS(t + 3));
        STEP9(pB0, pB1, pA0, pA1, t + 1, ks_cur, false, true); SYNC9(3); ROT();
    }
    for (; t < NT; t += 2) {
        const bool k3 = t + 3 < NT, v2 = t + 2 < NT;
        if (k3) { DMA_KA(ks_n2); DMA_KB(ks_n2); } if (v2) DMA_V(VS(t + 2));
        STEP9(pA0, pA1, pB0, pB1, t, ks_cur, true, true);
        if (k3) SYNC9(3); else SYNC9(0);
        ROT();
        const bool k3b = t + 4 < NT, v2b = t + 3 < NT;
        if (k3b) { DMA_KA(ks_n2); DMA_KB(ks_n2); } if (v2b) DMA_V(VS(t + 3));
        if (t + 2 < NT) STEP9(pB0, pB1, pA0, pA1, t + 1, ks_cur, true, true); else STEP9(pB0, pB1, pA0, pA1, t + 1, ks_cur, true, false);
        if (k3b) SYNC9(3); else SYNC9(0);
        ROT();
    }
#undef VS
#undef QPIN
#undef LOADT
#undef DMA_KA
#undef DMA_KB
#undef DMA_V
#undef GLDS16
#undef TILE_SYNC
#undef ACT
#undef SB
#undef SGB
#undef KFRAG
#undef QKCHAIN
#undef MASK2
#undef DECIDE2
#undef EXPSUMPACK
#undef PV8
#undef STEP9
#undef ROT
#undef SYNC9
    { auto rr = __builtin_amdgcn_permlane32_swap(__float_as_uint(l_run), __float_as_uint(l_run), false, false); l_run = __uint_as_float(rr[0]) + __uint_as_float(rr[1]); }
    if (hi == 0) wsf[32 + r32] = l_run; asm volatile("s_waitcnt lgkmcnt(0)" ::: "memory");
    float rli[16];
#pragma unroll
    for (int g = 0; g < 4; ++g) { const f32x4 a = *(const ALAS f32x4*)(wsf + 32 + 8 * g + 4 * hi);
#pragma unroll
        for (int i = 0; i < 4; ++i) rli[4 * g + i] = __builtin_amdgcn_rcpf(a[i]); }
    bf16_t* Ow = O + (tok0 + q0 + wid * 32) * OP + h * 64;
    { ALAS bf16_t* stg = (ALAS bf16_t*)(shm + L_OST) + wid * 2048;
#pragma unroll
      for (int r = 0; r < 16; ++r) { const int orow = crow(r, hi);
#pragma unroll
          for (int d0 = 0; d0 < 2; ++d0) stg[orow * 64 + d0 * 32 + r32] = (bf16_t)(cvtpk(o[d0][r] * rli[r], 0.f) & 0xffffu); }
      asm volatile("s_waitcnt lgkmcnt(0)" ::: "memory");
#pragma unroll
      for (int i = 0; i < 4; ++i) { const int row = i * 8 + (lane >> 3), ch = lane & 7; const u32x4 v = *(const ALAS u32x4*)(stg + row * 64 + ch * 8); *(u32x4*)(Ow + (long)row * OP + ch * 8) = v; } }
}
#undef ALAS
}
#define GAS __attribute__((address_space(1)))
#define LAS __attribute__((address_space(3)))
typedef unsigned short bf16;
typedef unsigned v4u __attribute__((ext_vector_type(4)));
typedef float f32x4 __attribute__((ext_vector_type(4)));
typedef short bf16x8 __attribute__((ext_vector_type(8)));
typedef GAS unsigned gu32;
typedef GAS unsigned long long gu64;
#define RLX_AGENT __ATOMIC_RELAXED, __HIP_MEMORY_SCOPE_AGENT
#define LDS_WAIT() asm volatile("s_waitcnt lgkmcnt(0)" ::: "memory")
#define VM_WAIT() asm volatile("s_waitcnt vmcnt(0)" ::: "memory")
__device__ __forceinline__ unsigned long long rt() { return __builtin_amdgcn_s_memrealtime(); }
__device__ __forceinline__ unsigned f2bf(float f) { unsigned u = __builtin_bit_cast(unsigned, f); return (u + 0x7fffu + ((u >> 16) & 1u)) >> 16; }
__device__ __forceinline__ unsigned pk2(float lo, float hi) { return f2bf(lo) | (f2bf(hi) << 16); }

#define XB_TMO      128
#define XB_XCNT(j)  (256  + 64 * (j))
#define XB_XSUB(j)  (1280 + 64 * (j))
#define XB_XGEN(j)  (2304 + 64 * (j))
#define XB_TOP      3328
#define XB_TOPGEN   3392
#define XCD_BAR_WORDS 3456
#define XB_SPIN_CAP (1u << 18)

__device__ __forceinline__ unsigned xb_ld(unsigned* p)              { return __hip_atomic_load(p, __ATOMIC_RELAXED, __HIP_MEMORY_SCOPE_AGENT); }
__device__ __forceinline__ unsigned xb_add(unsigned* p, unsigned v) { return __hip_atomic_fetch_add(p, v, __ATOMIC_RELAXED, __HIP_MEMORY_SCOPE_AGENT); }
__device__ __forceinline__ unsigned xb_xcc_id() { return (unsigned)__builtin_amdgcn_s_getreg((3 << 11) | 20) & 0xFu; }
#define XB_SPIN(cond, bar) do { unsigned _sp = 0; while (cond) { __builtin_amdgcn_s_sleep(1); \
    if ((++_sp & 255u) == 0u) { if (xb_ld(&(bar)[XB_TMO])) break; if (_sp > XB_SPIN_CAP) { atomicAdd(&(bar)[XB_TMO], 1u); break; } } } } while (0)

struct XcdBarrier {
    unsigned* bar; unsigned x;
    volatile LAS unsigned* st;
};

__device__ __forceinline__ XcdBarrier xcd_barrier_post(unsigned* bar, volatile LAS unsigned* st) {
    XcdBarrier b; b.bar = bar; b.x = xb_xcc_id(); b.st = st;
    if (threadIdx.x == 0) (void)xb_add(&bar[XB_XCNT(b.x)], 1u);
    return b;
}
__device__ __forceinline__ void xcd_barrier_complete(unsigned* bar, unsigned x, unsigned& nloc, unsigned& nx) {
    const unsigned G = gridDim.x * gridDim.y * gridDim.z;
    unsigned sum, cnt, mine, sp = 0u;
    for (;;) {
        sum = 0u; cnt = 0u; mine = 0u;
#pragma unroll
        for (unsigned j = 0; j < 16; ++j) { const unsigned c = xb_ld(&bar[XB_XCNT(j)]); sum += c; cnt += (c > 0u) ? 1u : 0u; mine = (j == x) ? c : mine; }
        if (sum == G) break;
        __builtin_amdgcn_s_sleep(1);
        if ((++sp & 255u) == 0u) { if (xb_ld(&bar[XB_TMO])) break; if (sp > XB_SPIN_CAP) { atomicAdd(&bar[XB_TMO], 1u); break; } }
    }
    nloc = mine > 0u ? mine : 1u; nx = cnt > 0u ? cnt : 1u;
}

__device__ __forceinline__ void xcd_barrier(const XcdBarrier& b) {
    asm volatile("s_waitcnt vmcnt(0)" ::: "memory");
    __syncthreads();
    if (threadIdx.x == 0) {
        unsigned* bar = b.bar;
        __builtin_amdgcn_s_waitcnt(0);
        unsigned nloc = b.st[0], nx = b.st[1];
        if (nloc == 0u) { xcd_barrier_complete(bar, b.x, nloc, nx); b.st[0] = nloc; b.st[1] = nx; }
        const unsigned old = xb_add(&bar[XB_XSUB(b.x)], 1u);
        const unsigned gen = old / nloc;
        if (old + 1u == (gen + 1u) * nloc) {
            __builtin_amdgcn_fence(__ATOMIC_RELEASE, "agent");
            asm volatile("s_waitcnt vmcnt(0)" ::: "memory");
            const unsigned og = xb_add(&bar[XB_TOP], 1u);
            const unsigned tg = og / nx;
            if (og + 1u == (tg + 1u) * nx) xb_add(&bar[XB_TOPGEN], 1u);
            else XB_SPIN(xb_ld(&bar[XB_TOPGEN]) == tg, bar);
            __builtin_amdgcn_fence(__ATOMIC_ACQUIRE, "agent");
            xb_add(&bar[XB_XGEN(b.x)], 1u);
            asm volatile("s_waitcnt vmcnt(0)" ::: "memory");
        } else {
            XB_SPIN(xb_ld(&bar[XB_XGEN(b.x)]) == gen, bar);
            __builtin_amdgcn_fence(__ATOMIC_ACQUIRE, "agent");
            asm volatile("s_waitcnt vmcnt(0)" ::: "memory");
        }
    }
    __syncthreads();
}
#ifndef MK_ABL
#define MK_ABL 0
#endif
#ifndef MK_REPEAT
#define MK_REPEAT (-1)
#endif
#ifndef MK_PRB_PHASE
#define MK_PRB_PHASE 1
#endif
#ifndef MK_STAMP_A
#define MK_STAMP_A 0
#define MK_STAMP_B 19
#endif
constexpr int NWAVES = 8;
constexpr int M_TOK = 16384, DMODEL = 1024, FHID = 2816, SEQLEN = 4096;
constexpr int N_PHASES = 10;
#ifndef MK_N_LAUNCHES
#define MK_N_LAUNCHES 1
#endif
constexpr int CW_BAR = 1024;
static_assert((CW_BAR + XCD_BAR_WORDS) * 4 <= (int)CTL_ZERO_BYTES, "barrier words inside the memset region");
constexpr int CW_GRP = 4608;
constexpr int CW_GOK = CW_GRP + 64 * 8;
constexpr int CW_CONV = CW_GOK + 64 * 8;
static_assert(CW_GRP >= CW_BAR + XCD_BAR_WORDS && (CW_CONV + 128) * 4 <= (int)CTL_ZERO_BYTES, "group words inside the memset region");
constexpr int RING_OFF = 0, RING_BYTES = 131072, LDSCTL_OFF = RING_BYTES, MISC_OFF = LDSCTL_OFF + 320, LDS_BYTES = 147456;

__device__ __constant__ float ROPE_INV_FREQ[16] = {1.0f, 0.5623413324356079f, 0.3162277638912201f, 0.17782793939113617f, 0.10000000149011612f, 0.05623413249850273f, 0.03162277489900589f, 0.017782794311642647f,
    0.009999999776482582f, 0.005623413249850273f, 0.003162277629598975f, 0.0017782794311642647f, 0.0010000000474974513f, 0.000562341301701963f, 0.0003162277571391314f, 0.00017782794020604342f};
__device__ __forceinline__ void sincos_acc(float af, float& s, float& c) {
    const double a = (double)af; const double k = rint(a * 0.6366197723675814);
    double r = fma(-k, 1.5707963267948966, a); r = fma(-k, 6.123233995736766e-17, r);
    const int q = ((int)k) & 3; const double r2 = r * r;
    double sp = -1.0 / 1307674368000.0; sp = fma(sp, r2, 1.0 / 6227020800.0); sp = fma(sp, r2, -1.0 / 39916800.0); sp = fma(sp, r2, 1.0 / 362880.0); sp = fma(sp, r2, -1.0 / 5040.0);
    sp = fma(sp, r2, 1.0 / 120.0); sp = fma(sp, r2, -1.0 / 6.0); sp = fma(sp, r2, 1.0); sp *= r;
    double cp = 1.0 / 20922789888000.0; cp = fma(cp, r2, -1.0 / 87178291200.0); cp = fma(cp, r2, 1.0 / 479001600.0); cp = fma(cp, r2, -1.0 / 3628800.0); cp = fma(cp, r2, 1.0 / 40320.0);
    cp = fma(cp, r2, -1.0 / 720.0); cp = fma(cp, r2, 1.0 / 24.0); cp = fma(cp, r2, -0.5); cp = fma(cp, r2, 1.0);
    const double ss = (q & 1) ? cp : sp, cc = (q & 1) ? sp : cp;
    s = (float)((q & 2) ? -ss : ss); c = (float)(((q + 1) & 2) ? -cc : cc);
}

struct Frame {
    LAS unsigned char* lds; volatile LAS unsigned* MISC; gu32* ctl;
    int tid, lane, wave, vcu, G;
    float* out; unsigned char* ws;
};
struct Args { const void* in[27]; float* out; unsigned char* ws; int ph_lo, ph_hi, li, pad; };
#define FIN(i) ((const float*)A.in[i])
__device__ __forceinline__ float wave_sum(float v) {
#pragma unroll
    for (int o = 1; o < 64; o <<= 1) v += __shfl_xor(v, o);
    return v;
}
__device__ __forceinline__ void st16_agent(bf16* p, v4u v) { asm volatile("global_store_dwordx4 %0, %1, off sc1" :: "v"(p), "v"(v) : "memory"); }
__device__ __forceinline__ void tr_item(const float* W, int ldn, int k0, int sc0, int ncol, bf16* dst, int Kp, int dr0, const float* gain, bool perm, LAS float* scr, int lane) {
    const int c32 = lane & 31;
    float wv[32], gv[32];
#pragma unroll
    for (int i = 0; i < 32; ++i) { const int kk = 2 * i + (lane >> 5); wv[i] = (c32 < ncol) ? W[(size_t)(k0 + kk) * ldn + sc0 + c32] : 0.f; gv[i] = gain ? gain[k0 + kk] : 1.0f; }
#pragma unroll
    for (int i = 0; i < 32; ++i) { const int kk = 2 * i + (lane >> 5); scr[kk * 33 + c32] = wv[i] * gv[i]; }
    LDS_WAIT(); asm volatile("" ::: "memory");
    const int c = lane & 7;
#pragma unroll
    for (int j = 0; j < 4; ++j) { const int n = (lane >> 3) + 8 * j; const LAS float* s = scr + (8 * c) * 33 + n;
        const int dn = perm ? (8 * ((n >> 2) & 3) + 4 * (n >> 4) + (n & 3)) : n;
        v4u o; o.x = pk2(s[0 * 33], s[1 * 33]); o.y = pk2(s[2 * 33], s[3 * 33]); o.z = pk2(s[4 * 33], s[5 * 33]); o.w = pk2(s[6 * 33], s[7 * 33]);
        st16_agent(dst + (size_t)(dr0 + dn) * Kp + k0 + 8 * c, o); }
    LDS_WAIT(); asm volatile("" ::: "memory");
}
__device__ __forceinline__ void zero_item(bf16* dst, int Kp, int dr0, int k0, int lane) {
    const int c = lane & 7;
#pragma unroll
    for (int j = 0; j < 4; ++j) { const int n = (lane >> 3) + 8 * j; st16_agent(dst + (size_t)(dr0 + n) * Kp + k0 + 8 * c, (v4u){0u, 0u, 0u, 0u}); }
}
constexpr int WD2_LO = (2 * 16 * 88 + 44 * 32) + 2 * 16 * 88, WD2_HI = 2 * (2 * 16 * 88 + 44 * 32);
constexpr int P0_ITEMS_NOW = 2 * 16 * 88, P0_NITEMS = 2 * (2 * 16 * 88 + 44 * 32) + 124 * 16 + 24 * 3 + 32 * 2 + 2 * 32 * 8 + 32 * 16 + 4 * 16 + 24;
__device__ __forceinline__ void p0_items(Frame& F, const Args& A, int lo, int hi, int gw, int NGW) {
    LAS float* scr = (LAS float*)(F.lds + RING_OFF + F.wave * 16384);
    const int lane = F.lane;
    unsigned char* ws = F.ws;
    constexpr int I_GU = 16 * 88, I_D = 44 * 32, I_FFN = 2 * I_GU + I_D, I_WIN = 124 * 16, I_QB = 24 * 3, I_KVB = 32 * 2, I_AB = 32 * 8, I_O = 32 * 16, I_ZW = 4 * 16, I_ZQ = 24;
    constexpr int NITEMS = 2 * I_FFN + I_WIN + I_QB + I_KVB + 2 * I_AB + I_O + I_ZW + I_ZQ;
    static_assert(NITEMS == P0_NITEMS, "item count");
    for (int it0 = lo + gw; it0 < hi; it0 += NGW) {
        int r = it0;
        if (r < 2 * I_FFN) { const int layer = r / I_FFN; r -= layer * I_FFN; const int mat = r / I_GU; r -= mat * I_GU;
            const float* gainp = layer ? FIN(23) : FIN(2);
            if (mat < 2) { const int kb = r / 88, nb = r % 88; const float* w = mat ? (layer ? FIN(25) : FIN(4)) : (layer ? FIN(24) : FIN(3));
                tr_item(w, FHID, 64 * kb, 32 * nb, 32, (bf16*)(ws + (layer ? WS_WGU2 : WS_WGU1)), 1024, 256 * (nb >> 2) + 32 * (nb & 3) + 128 * mat, gainp, false, scr, lane); }
            else { const int kb = r / 32, nb = r % 32; tr_item(layer ? FIN(26) : FIN(5), DMODEL, 64 * kb, 32 * nb, 32, (bf16*)(ws + (layer ? WS_WD2 : WS_WD1)), FHID, 32 * nb, nullptr, false, scr, lane); }
            continue; }
        r -= 2 * I_FFN;
        if (r < I_WIN) { const int kb = r / 124, nb = r % 124; int sc0, dr0, ncol = 32; bool perm = false;
            if (nb < 6) { sc0 = 32 * nb; dr0 = 32 * nb; }
            else if (nb < 10) { sc0 = 192 + 32 * (nb - 6); dr0 = 256 + 32 * (nb - 6); }
            else if (nb == 10) { sc0 = 320; dr0 = 384; perm = true; }
            else if (nb == 11) { sc0 = 1888; dr0 = 416; ncol = 8; }
            else if (nb < 60) { const int j = nb - 12, kind = j >> 4, jj = j & 15, h = jj >> 1, bj = jj & 1; sc0 = 352 + 512 * kind + 64 * h + 32 * bj; dr0 = 512 + 512 * kind + 256 * (h >> 2) + 128 * bj + 32 * (h & 3); }
            else { const int j = nb - 60; sc0 = 1896 + 32 * j; dr0 = 2048 + 32 * j; }
            tr_item(FIN(7), 3944, 64 * kb, sc0, ncol, (bf16*)(ws + WS_WIN), 1024, dr0, FIN(6), perm, scr, lane); continue; }
        r -= I_WIN;
        if (r < I_QB) { const int kb = r / 24, nb = r % 24; int sc0, dr0; bool perm = false;
            if (nb < 16) { const int h = nb >> 1, bj = nb & 1; sc0 = 96 * h + 32 * bj; dr0 = 256 * (h >> 2) + 128 * bj + 32 * (h & 3); }
            else { const int h = nb - 16; sc0 = 96 * h + 64; dr0 = 512 + 128 * (h >> 2) + 32 * (h & 3); perm = true; }
            tr_item(FIN(9), 768, 64 * kb, sc0, 32, (bf16*)(ws + WS_WQB), 256, dr0, FIN(8), perm, scr, lane); continue; }
        r -= I_QB;
        if (r < I_KVB) { const int kb = r / 32, nb = r % 32; const int j = nb & 15, h = j >> 1, bj = j & 1, isv = nb >> 4;
            tr_item(FIN(11), 1024, 64 * kb, 128 * h + 64 * isv + 32 * bj, 32, (bf16*)(ws + WS_WKVB), 128, 512 * isv + 256 * (h >> 2) + 128 * bj + 32 * (h & 3), FIN(10), false, scr, lane); continue; }
        r -= I_KVB;
        if (r < 2 * I_AB) { const int which = r / I_AB; r -= which * I_AB; const int kb = r / 32, nb = r % 32;
            tr_item(which ? FIN(20) : FIN(19), DMODEL, 64 * kb, 32 * nb, 32, (bf16*)(ws + WS_WAB), 512, 1024 * which + 32 * nb, nullptr, false, scr, lane); continue; }
        r -= 2 * I_AB;
        if (r < I_O) { const int kb = r / 32, nb = r % 32; tr_item(FIN(22), DMODEL, 64 * kb, 32 * nb, 32, (bf16*)(ws + WS_WO), 1024, 32 * nb, nullptr, false, scr, lane); continue; }
        r -= I_O;
        if (r < I_ZW) { const int kb = r >> 2, rb = r & 3; zero_item((bf16*)(ws + WS_WIN), 1024, (rb < 2 ? 192 + 32 * rb : 448 + 32 * (rb - 2)), 64 * kb, lane); continue; }
        r -= I_ZW;
        zero_item((bf16*)(ws + WS_WQB), 256, 32 * r, 192, lane);
    }
}
__device__ __forceinline__ void p0_prologue(Frame& F, const Args& A) {
    const int gw = F.vcu * NWAVES + F.wave, NGW = F.G * NWAVES, lane = F.lane;
    unsigned char* ws = F.ws;
    p0_items(F, A, 0, (F.G == 256) ? P0_ITEMS_NOW : P0_NITEMS, gw, NGW);
    { const float* x = FIN(0); bf16* xb = (bf16*)(ws + WS_XB); float* ss0 = (float*)(ws + WS_SS0);
      for (int m0 = gw; m0 < M_TOK * ((MK_REPEAT == 0 || MK_REPEAT == 11) ? 2 : 1); m0 += NGW) { const int m = m0 % M_TOK; const GAS f32x4* xr = (const GAS f32x4*)(x + (size_t)m * DMODEL) + lane; f32x4 v[4]; float s = 0.f;
#pragma unroll
          for (int j = 0; j < 4; ++j) { v[j] = xr[64 * j]; s += (v[j].x * v[j].x + v[j].y * v[j].y) + (v[j].z * v[j].z + v[j].w * v[j].w); }
          s = wave_sum(s);
          GAS unsigned long long* o8 = (GAS unsigned long long*)(xb + (size_t)m * DMODEL) + lane;
#pragma unroll
          for (int j = 0; j < 4; ++j) o8[64 * j] = (unsigned long long)pk2(v[j].x, v[j].y) | ((unsigned long long)pk2(v[j].z, v[j].w) << 32);
          if (lane == 0) *(GAS f32x4*)(ss0 + 4 * (size_t)m) = (f32x4){s, 0.f, 0.f, 0.f}; } }
    { float* par = (float*)(ws + WS_PAR);
      for (int i = (F.vcu * NWAVES + F.wave) * 64 + lane; i < PAR_N; i += F.G * NWAVES * 64) { float v = 0.f;
          if (i < 64) v = FIN(16)[i]; else if (i < 128) v = FIN(17)[i - 64]; else if (i < 160) v = FIN(15)[i - 128]; else if (i < 168) v = FIN(18)[i - 160];
          else if (i >= 192 && i < 256) v = FIN(12)[i - 192]; else if (i >= 256 && i < 288) v = FIN(13)[i - 256]; else if (i >= 320 && i < 384) v = FIN(14)[i - 320]; else if (i >= 1024) v = FIN(21)[i - 1024];
          par[i] = v; } }
    { const int* pos = (const int*)A.in[1]; float* cosT = (float*)(ws + WS_COS); float* sinT = (float*)(ws + WS_SIN);
      for (int idx = (F.vcu * NWAVES + F.wave) * 64 + lane; idx < M_TOK * 16; idx += F.G * NWAVES * 64) { float sn, cs; sincos_acc((float)pos[idx >> 4] * ROPE_INV_FREQ[idx & 15], sn, cs); cosT[idx] = cs; sinT[idx] = sn; } }
}
__device__ __forceinline__ void cum_phase(Frame& F) {
    for (int bh = F.vcu; bh < 32; bh += F.G) { const int b = bh >> 3, h = bh & 7; const float* lf = (const float*)(F.ws + WS_LOGF) + ((size_t)b * SEQLEN) * 8 + h;
        LAS float* wsum = (LAS float*)(F.lds + RING_OFF);
        float v[8], run = 0.f;
#pragma unroll
        for (int i = 0; i < 8; ++i) { run += lf[(size_t)(8 * F.tid + i) * 8]; v[i] = run; }
        float inc = run;
#pragma unroll
        for (int o = 1; o < 64; o <<= 1) { const float t = __shfl_up(inc, o); if (F.lane >= o) inc += t; }
        if (F.lane == 63) wsum[F.wave] = inc;
        __syncthreads();
        float base = inc - run;
        for (int w = 0; w < F.wave; ++w) base += wsum[w];
#pragma unroll
        for (int i = 0; i < 8; ++i) { const float val = -1.4426950408889634f * (v[i] + base);
            const unsigned hi_ = f2bf(val); const float r1 = val - __uint_as_float(hi_ << 16); const unsigned mid_ = f2bf(r1); const float r2 = r1 - __uint_as_float(mid_ << 16); const unsigned lo_ = f2bf(r2);
            GAS v4u* dst = (GAS v4u*)((bf16*)(F.ws + WS_KAUG) + (((size_t)b * SEQLEN + 8 * F.tid + i) * 8 + h) * 16);
            dst[0] = (v4u){hi_ | (mid_ << 16), lo_, 0u, 0u}; dst[1] = (v4u){0u, 0u, 0u, 0u}; }
        __syncthreads(); }
}

__device__ __forceinline__ void grp_barrier(const Frame& F, int conv, unsigned need) {
    asm volatile("s_waitcnt vmcnt(0)" ::: "memory");
    __syncthreads();
    if (threadIdx.x == 0) {
        unsigned* bar = (unsigned*)(F.ctl + CW_BAR);
        __builtin_amdgcn_s_waitcnt(0);
        const unsigned g = blockIdx.x & 7u, size = (unsigned)F.G >> 3;
        unsigned* cnt = (unsigned*)(F.ctl + CW_GRP + 64 * g);
        if (F.MISC[12] == 0u) { __builtin_amdgcn_fence(__ATOMIC_RELEASE, "agent"); asm volatile("s_waitcnt vmcnt(0)" ::: "memory"); }
        const unsigned old = xb_add(cnt, 1u), target = (old / size + 1u) * size;
        XB_SPIN(xb_ld(cnt) < target, bar);
        if (conv >= 0) { unsigned* cw = (unsigned*)(F.ctl + conv); XB_SPIN(xb_ld(cw) < need, bar); }
        __builtin_amdgcn_fence(__ATOMIC_ACQUIRE, "agent");
        asm volatile("s_waitcnt vmcnt(0)" ::: "memory");
    }
    __syncthreads();
}
__device__ __forceinline__ void conv_done(const Frame& F, int conv) {
    asm volatile("s_waitcnt vmcnt(0)" ::: "memory");
    __syncthreads();
    if (threadIdx.x == 0) (void)xb_add((unsigned*)(F.ctl + conv), 1u);
}

__global__ void __launch_bounds__(NWAVES * 64, 2) mega_fwd(Args A) {
    extern __shared__ __attribute__((aligned(16))) unsigned char lds[];
    Frame F;
    F.lds = (LAS unsigned char*)lds; F.MISC = (volatile LAS unsigned*)(F.lds + MISC_OFF);
    F.tid = threadIdx.x; F.lane = F.tid & 63; F.wave = __builtin_amdgcn_readfirstlane(F.tid >> 6);
    F.G = gridDim.x; { const int bx = blockIdx.x; F.vcu = (F.G % 8 == 0) ? (bx % 8) * (F.G / 8) + bx / 8 : bx; }
    F.out = A.out; F.ws = A.ws; F.ctl = (gu32*)(A.ws + WS_CTL);
    unsigned char* ws = A.ws;
    for (int u = F.tid; u < (LDS_BYTES - LDSCTL_OFF) / 4; u += NWAVES * 64) ((LAS unsigned*)(F.lds + LDSCTL_OFF))[u] = 0u;
    __syncthreads();
    XcdBarrier bar; bar.bar = (unsigned*)(F.ctl + CW_BAR); bar.x = 0; bar.st = nullptr;
    if (MK_N_LAUNCHES == 1) bar = xcd_barrier_post((unsigned*)(F.ctl + CW_BAR), F.MISC + 8);
    const bool gseam = (MK_N_LAUNCHES == 1) && F.G == 256;
    if (gseam && F.tid == 0 && xb_xcc_id() == (blockIdx.x & 7u)) (void)xb_add((unsigned*)(F.ctl + CW_GOK + 64 * (blockIdx.x & 7)), 1u);
    const int lo = A.ph_lo, hi = A.ph_hi;
#define REP(k) for (int rep_ = 0; rep_ < (((k) == MK_REPEAT && (k) != 0) ? 2 : 1); ++rep_)
#if defined(MK_PRB)
#define STAMP(i) do { if (blockIdx.x == 0 && F.tid == 0) { F.MISC[16 + (i)] = (unsigned)rt(); g_prb_on = ((i) == 2 * MK_PRB_PHASE) ? 1 : 0; } } while (0)
#else
#define STAMP(i) do { } while (0)
#endif
#define IN(k) (lo <= (k) && (k) < hi)
#define SEAM_G(k, conv, need) do { STAMP(2 * (k) + 1); if (IN(k) && IN((k) + 1)) { if (gseam) grp_barrier(F, conv, need); else xcd_barrier(bar); } STAMP(2 * (k) + 2); } while (0)
#define SEAM(k) do { STAMP(2 * (k) + 1); if (IN(k) && IN((k) + 1)) { xcd_barrier(bar); if (MK_REPEAT == 20) xcd_barrier(bar); } STAMP(2 * (k) + 2); } while (0)
    using pg8::Gemm; using pg8::StaticOrder;
    bf16* XB = (bf16*)(ws + WS_XB); bf16* HB = (bf16*)(ws + WS_H);
    float* SS0 = (float*)(ws + WS_SS0); float* SS1 = (float*)(ws + WS_SS1); float* SS2 = (float*)(ws + WS_SS2);

    STAMP(0);
#if defined(MK_PRB)
    if (blockIdx.x == 0 && F.tid == 0) { for (int i = 0; i < 8; ++i) g_prb[i] = 0; g_prb_on = 0; }
#endif
    if (IN(0)) { REP(0) p0_prologue(F, A); } SEAM(0);
    if (gseam && F.tid == 0) F.MISC[12] = (xb_ld((unsigned*)(F.ctl + CW_GOK + 64 * (blockIdx.x & 7))) == (unsigned)F.G / 8u) ? 1u : 0u;
    if (IN(1)) REP(1) { Gemm g{XB, (const bf16*)(ws + WS_WGU1), M_TOK, 2 * FHID, DMODEL}; StaticOrder S; S.init(M_TOK, 2 * FHID, F.G, (int)blockIdx.x);
        pg8::EpiSwiglu E{HB, SS0, FHID}; pg8::gemm_phase<pg8::EpiSwiglu, StaticOrder, true, true>(F.lds + RING_OFF, g, S, E);
        if (F.G == 256 && blockIdx.x >= 128) { p0_items(F, A, P0_ITEMS_NOW, WD2_LO, ((int)blockIdx.x - 128) * NWAVES + F.wave, 128 * NWAVES); p0_items(F, A, WD2_HI, P0_NITEMS, ((int)blockIdx.x - 128) * NWAVES + F.wave, 128 * NWAVES); if (gseam) conv_done(F, CW_CONV); } } SEAM_G(1, CW_CONV, 128u);
    if (IN(2)) REP(2) { Gemm g{HB, (const bf16*)(ws + WS_WD1), M_TOK, DMODEL, FHID}; StaticOrder S; S.init(M_TOK, DMODEL, F.G, (int)blockIdx.x);
        pg8::EpiResid<true, true, true> E{XB, nullptr, XB, SS1}; pg8::gemm_phase<pg8::EpiResid<true, true, true>, StaticOrder, false, true>(F.lds + RING_OFF, g, S, E); } SEAM(2);
    if (IN(3)) REP(3) { Gemm g{XB, (const bf16*)(ws + WS_WIN), M_TOK, 4096, DMODEL}; StaticOrder S; S.init(M_TOK, 4096, F.G, (int)blockIdx.x);
        pg8::EpiWin E{ws};
        pg8::gemm_phase<pg8::EpiWin, StaticOrder, true, true>(F.lds + RING_OFF, g, S, E); } SEAM(3);
    if (IN(4)) REP(4) { cum_phase(F);
        { int kq = 256; asm volatile("" : "+s"(kq)); Gemm g{(const bf16*)(ws + WS_QLAT), (const bf16*)(ws + WS_WQB), M_TOK, 768, kq}; StaticOrder S; S.init(M_TOK, 768, F.G, (int)blockIdx.x);
          pg8::EpiMlaQ E{ws}; pg8::gemm_phase<pg8::EpiMlaQ, StaticOrder, true, true>(F.lds + RING_OFF, g, S, E); }
        { int kq = 128; asm volatile("" : "+s"(kq)); Gemm g{(const bf16*)(ws + WS_KVLAT), (const bf16*)(ws + WS_WKVB), M_TOK, 1024, kq}; StaticOrder S; S.init(M_TOK, 1024, F.G, (int)blockIdx.x);
          pg8::EpiMlaKV E{ws, (bf16*)F.out}; pg8::gemm_phase<pg8::EpiMlaKV, StaticOrder, true, true>(F.lds + RING_OFF, g, S, E); } } SEAM(4);
    if (IN(5)) REP(5) { bf16* omla = (bf16*)(ws + WS_YCAT); bf16* ofox = (bf16*)(ws + WS_QF);
#if MK_REPEAT == 5
        if (rep_ == 0) { bf16* dmy = (bf16*)F.out + 16 * MiB / 2;
            for (int v = F.vcu; v < 256; v += F.G) { const int bh = v >> 3, s = v & 7, b = bh >> 3, h = bh & 7;
                for (int i = 0; i < 2; ++i) att::attn_unit<6, false, 768, 96, 512, 32, 0, 512, 512, MK_ABL>(b, h, i ? 15 - s : s, (const bf16*)(ws + WS_QM), (const bf16*)(ws + WS_KM), (const bf16*)(ws + WS_KR), (const bf16*)F.out, dmy, (LAS char*)F.lds);
                for (int i = 0; i < 2; ++i) att::attn_unit<5, true, 512, 64, 512, 128, 16, 512, 512, MK_ABL>(b, h, i ? 15 - s : s, (const bf16*)(ws + WS_QF), (const bf16*)(ws + WS_KF), (const bf16*)(ws + WS_KAUG), (const bf16*)(ws + WS_VF), dmy, (LAS char*)F.lds); }
            continue; }
#endif
        if (F.wave >= 4) __builtin_amdgcn_s_setprio(1);
        for (int v = F.vcu; v < 256; v += F.G) { const int bh = v >> 3, s = v & 7, b = bh >> 3, h = bh & 7;
            for (int i = 0; i < 2; ++i) att::attn_unit<6, false, 768, 96, 512, 32, 0, 512, 512>(b, h, i ? 15 - s : s, (const bf16*)(ws + WS_QM), (const bf16*)(ws + WS_KM), (const bf16*)(ws + WS_KR), (const bf16*)F.out, omla, (LAS char*)F.lds);
            for (int i = 0; i < 2; ++i) att::attn_unit9<5, true, 512, 64, 512, 128, 16, 512, 512>(b, h, i ? 15 - s : s, (const bf16*)(ws + WS_QF), (const bf16*)(ws + WS_KF), (const bf16*)(ws + WS_KAUG), (const bf16*)(ws + WS_VF), ofox, (LAS char*)F.lds); }
        __builtin_amdgcn_s_setprio(0); } SEAM(5);
    if (IN(6)) REP(6) { Gemm g{(const bf16*)(ws + WS_YCAT), (const bf16*)(ws + WS_WAB), 2 * M_TOK, 2048, 512}; pg8::BranchOrder S; S.init(F.G, (int)blockIdx.x);
        pg8::EpiBranch E{ws}; pg8::gemm_phase<pg8::EpiBranch, pg8::BranchOrder, true, true>(F.lds + RING_OFF, g, S, E); } SEAM_G(6, -1, 0u);
    if (IN(7)) { Gemm g{(const bf16*)(ws + WS_MIXED), (const bf16*)(ws + WS_WO), M_TOK, DMODEL, DMODEL}; StaticOrder S; S.init(M_TOK, DMODEL, F.G, (int)blockIdx.x);
        pg8::EpiResid<false, true, true> E{XB, nullptr, (bf16*)(ws + WS_X2B), SS2}; pg8::gemm_phase<pg8::EpiResid<false, true, true>, StaticOrder, false, true>(F.lds + RING_OFF, g, S, E); } SEAM(7);
    if (IN(8)) REP(8) { Gemm g{(const bf16*)(ws + WS_X2B), (const bf16*)(ws + WS_WGU2), M_TOK, 2 * FHID, DMODEL}; StaticOrder S; S.init(M_TOK, 2 * FHID, F.G, (int)blockIdx.x);
        pg8::EpiSwiglu E{HB, SS2, FHID}; pg8::gemm_phase<pg8::EpiSwiglu, StaticOrder, true, true>(F.lds + RING_OFF, g, S, E);
        if (F.G == 256 && blockIdx.x >= 128) { p0_items(F, A, WD2_LO, WD2_HI, ((int)blockIdx.x - 128) * NWAVES + F.wave, 128 * NWAVES); if (gseam) conv_done(F, CW_CONV + 64); } } SEAM_G(8, CW_CONV + 64, 128u);
    if (IN(9)) { Gemm g{HB, (const bf16*)(ws + WS_WD2), M_TOK, DMODEL, FHID}; StaticOrder S; S.init(M_TOK, DMODEL, F.G, (int)blockIdx.x);
        pg8::EpiResid<true, true, false> E{(const bf16*)(ws + WS_X2B), F.out, nullptr, nullptr}; pg8::gemm_phase<pg8::EpiResid<true, true, false>, StaticOrder, false, true>(F.lds + RING_OFF, g, S, E); }
    STAMP(19);
#if defined(MK_PRB)
    if (blockIdx.x == 0 && F.tid == 0) { unsigned long long v = g_prb[MK_PRB & 7]; if (MK_PRB == 6) v = (unsigned long long)(F.MISC[16 + MK_STAMP_B] - F.MISC[16 + MK_STAMP_A]);
        const unsigned long long wait = 4ull * v, t0 = rt(); while (rt() - t0 < wait) __builtin_amdgcn_s_sleep(8); }
#endif
#undef IN
#undef SEAM
#undef SEAM_G
}

static int mega_setup() {
    static int grid = 0;
    if (grid == 0) {
        int dev = 0, cus = 0;
        if (hipGetDevice(&dev) != hipSuccess || hipDeviceGetAttribute(&cus, hipDeviceAttributeMultiprocessorCount, dev) != hipSuccess) { fprintf(stderr, "mega: device query failed\n"); grid = -1; return grid; }
        if (hipFuncSetAttribute((const void*)mega_fwd, hipFuncAttributeMaxDynamicSharedMemorySize, LDS_BYTES) != hipSuccess) { fprintf(stderr, "mega: hipFuncSetAttribute failed\n"); grid = -1; return grid; }
        int per_cu = 0;
        if (hipOccupancyMaxActiveBlocksPerMultiprocessor(&per_cu, (const void*)mega_fwd, NWAVES * 64, LDS_BYTES) != hipSuccess || per_cu < 1)
            fprintf(stderr, "mega: the occupancy query reports %d workgroups per CU (need 1): check the build's VGPR / LDS numbers\n", per_cu);
        (void)hipGetLastError();
        grid = cus;
        if (grid != 256) fprintf(stderr, "mega: %d CUs; the one-unit-per-workgroup phases assume 256\n", grid);
    }
    return grid;
}
static void mega_launch(void* const* d_in, float* d_out, unsigned char* ws, hipStream_t stream, int ph_lo, int ph_hi) {
    const int grid = mega_setup(); if (grid <= 0) return;
    Args a{};
    for (int i = 0; i < 27; ++i) a.in[i] = d_in[i];
    a.out = d_out; a.ws = ws; a.ph_lo = ph_lo; a.ph_hi = ph_hi; a.li = 0; a.pad = 0;
    hipLaunchKernelGGL(mega_fwd, dim3(grid), dim3(NWAVES * 64), LDS_BYTES, stream, a);
}
extern "C" void kernel_launch(void* const* d_in, const int* in_sizes, int n_in, void* d_out, int out_size, void* d_ws, size_t ws_size, hipStream_t stream) {
    if (n_in != 27 || in_sizes[0] != M_TOK * DMODEL || out_size != M_TOK * DMODEL || ws_size < WS_END) { fprintf(stderr, "kernel_launch: unexpected problem shape; nothing launched\n"); return; }
    unsigned char* ws = (unsigned char*)d_ws;
    (void)hipMemsetAsync(ws + WS_CTL, 0, CTL_ZERO_BYTES, stream);
    if (MK_N_LAUNCHES == 1) mega_launch(d_in, (float*)d_out, ws, stream, 0, N_PHASES);
    else for (int p = 0; p < N_PHASES; ++p) mega_launch(d_in, (float*)d_out, ws, stream, p, p + 1);
}
```
